# Optimizing an MI355X kernel written in HIP

```python
import jax
import jax.numpy as jnp
from jax import lax
import numpy as np

D_MODEL = 2048
BATCH = 1
SEQ = 8192
DEPTH = 2

HGRN_HEADS = 8
HGRN_HEAD_K = 128
HGRN_HEAD_V = D_MODEL // 2 // HGRN_HEADS
HGRN_KEY = HGRN_HEADS * HGRN_HEAD_K
HGRN_VAL = HGRN_HEADS * HGRN_HEAD_V
GLA_HEADS = 4
GLA_VAL = D_MODEL // 2
GLA_KEY = GLA_VAL // 2
GLA_HEAD_K = GLA_KEY // GLA_HEADS
GLA_HEAD_V = GLA_VAL // GLA_HEADS
GLA_GATE_RANK = 16
GLA_GATE_NORMALIZER = 16.0
CHUNK = 64
D_FF_DENSE = 5632
N_EXPERTS = 8
TOP_K = 2
D_FF_EXPERT = 7168
N_DENSE = (DEPTH + 1) // 2
N_MOE = DEPTH // 2
EPS = 1e-6

IN_SPLITS = (HGRN_KEY, HGRN_KEY, HGRN_VAL, HGRN_VAL, GLA_KEY, GLA_KEY, GLA_VAL, GLA_VAL, GLA_GATE_RANK, D_MODEL, D_MODEL)
D_IN = sum(IN_SPLITS)

kernel_name = "hybrid_hgrn2_gla_moe_block"


def rms_norm(x, w):
    x32 = x.astype(jnp.float32)
    y = x32 * lax.rsqrt(jnp.mean(x32 * x32, axis=-1, keepdims=True) + EPS)
    return (y * w.astype(jnp.float32)).astype(x.dtype)


def split_heads(a, n_heads):
    b, t, _ = a.shape
    return a.reshape(b, t, n_heads, -1).transpose(0, 2, 1, 3)


def chunked_gated_linear_attention(q, k, v, log_f, scale):
    b, h, t, dk = q.shape
    dv = v.shape[-1]
    n_chunks = t // CHUNK

    def to_chunks(a):
        return a.reshape(b, h, n_chunks, CHUNK, a.shape[-1]).transpose(2, 0, 1, 3, 4)

    causal = jnp.tril(jnp.ones((CHUNK, CHUNK), dtype=bool))[:, :, None]

    def step(state, inp):
        qc, kc, vc, gc = inp
        qc = qc.astype(jnp.float32) * scale
        kc = kc.astype(jnp.float32)
        vc = vc.astype(jnp.float32)
        cum = jnp.cumsum(gc.astype(jnp.float32), axis=2)
        rel = cum[:, :, :, None, :] - cum[:, :, None, :, :]
        decay = jnp.exp(jnp.where(causal, rel, -jnp.inf))
        scores = jnp.einsum("bhid,bhjd,bhijd->bhij", qc, kc, decay)
        o = (jnp.einsum("bhij,bhjv->bhiv", scores, vc)
             + jnp.einsum("bhid,bhdv->bhiv", qc * jnp.exp(cum), state))
        last = cum[:, :, -1:, :]
        state = (jnp.exp(last[:, :, 0, :])[..., None] * state
                 + jnp.einsum("bhjd,bhjv->bhdv", kc * jnp.exp(last - cum), vc))
        return state, o

    state0 = jnp.zeros((b, h, dk, dv), jnp.float32)
    _, o = lax.scan(step, state0, (to_chunks(q), to_chunks(k), to_chunks(v), to_chunks(log_f)))
    return o.transpose(1, 2, 0, 3, 4).reshape(b, h, t, dv)


def gated_head_norm(o, w, gate):
    b, h, t, d = o.shape
    o = o.transpose(0, 2, 1, 3)
    o = o * lax.rsqrt(jnp.mean(o * o, axis=-1, keepdims=True) + EPS) * w.astype(jnp.float32)
    return (o.reshape(b, t, h * d) * jax.nn.silu(gate.astype(jnp.float32))).astype(gate.dtype)


def hybrid_mixer(h, layer, w_in, lower_bound_logits, gk_up_w, gk_up_b, hgrn_norm_w, gla_norm_w,
                 w_proj_a, w_proj_b, w_out):
    u = h @ w_in
    cuts = np.cumsum(IN_SPLITS)[:-1].tolist()
    a_q, a_f, a_i, a_g, b_q, b_k, b_v, b_g, b_gk, m_a, m_b = jnp.split(u, cuts, axis=-1)

    bounds = jnp.cumsum(jax.nn.softmax(lower_bound_logits.astype(jnp.float32), axis=0), axis=0)
    lb = bounds[layer] - bounds[0]
    z = a_f.astype(jnp.float32)
    log_f = jnp.logaddexp(jnp.log(lb), jnp.log1p(-lb) + jax.nn.log_sigmoid(z))
    k_a = (1.0 - lb) * jax.nn.sigmoid(-z)
    o_a = chunked_gated_linear_attention(
        split_heads(a_q, HGRN_HEADS), split_heads(k_a, HGRN_HEADS),
        split_heads(a_i, HGRN_HEADS), split_heads(log_f, HGRN_HEADS), HGRN_HEAD_K ** -0.5)
    y_a = gated_head_norm(o_a, hgrn_norm_w, a_g)

    log_gk = jax.nn.log_sigmoid((b_gk @ gk_up_w + gk_up_b).astype(jnp.float32)) / GLA_GATE_NORMALIZER
    o_b = chunked_gated_linear_attention(
        split_heads(b_q, GLA_HEADS), split_heads(b_k, GLA_HEADS),
        split_heads(b_v, GLA_HEADS), split_heads(log_gk, GLA_HEADS), GLA_HEAD_K ** -0.5)
    y_b = gated_head_norm(o_b, gla_norm_w, b_g)

    merged = jax.nn.sigmoid(m_a) * (y_a @ w_proj_a) + jax.nn.sigmoid(m_b) * (y_b @ w_proj_b)
    return merged @ w_out


def swiglu(h, w_gate, w_up, w_down):
    return (jax.nn.silu(h @ w_gate) * (h @ w_up)) @ w_down


def moe_swiglu(h, router_w, router_b, w_gate, w_up, w_down):
    logits = (h @ router_w).astype(jnp.float32) + router_b.astype(jnp.float32)
    top_logits, top_idx = lax.top_k(logits, TOP_K)
    top_w = jax.nn.softmax(top_logits, axis=-1)
    combine = jnp.sum(jax.nn.one_hot(top_idx, N_EXPERTS, dtype=jnp.float32) * top_w[..., None],
                      axis=-2).astype(h.dtype)
    out = jnp.zeros_like(h)
    for e in range(N_EXPERTS):
        out = out + combine[..., e:e + 1] * swiglu(h, w_gate[e], w_up[e], w_down[e])
    return out


def setup_inputs(seed: int = 0) -> dict:
    key = jax.random.key(seed)
    ks = jax.random.split(key, 21)
    f32 = jnp.float32

    def normal(k, shape, scale):
        return jax.random.normal(k, shape, f32) * scale

    def gain(k, shape):
        return 1.0 + 0.02 * jax.random.normal(k, shape, f32)

    return {
        "x": normal(ks[0], (BATCH, SEQ, D_MODEL), 1.0),
        "mix_norm_w": gain(ks[1], (DEPTH, D_MODEL)),
        "w_in": normal(ks[2], (DEPTH, D_MODEL, D_IN), D_MODEL ** -0.5),
        "lower_bound_logits": normal(ks[3], (DEPTH, HGRN_KEY), 1.0),
        "gk_up_w": normal(ks[4], (DEPTH, GLA_GATE_RANK, GLA_KEY), GLA_GATE_RANK ** -0.5),
        "gk_up_b": normal(ks[5], (DEPTH, GLA_KEY), 0.1),
        "hgrn_norm_w": gain(ks[6], (DEPTH, HGRN_HEAD_V)),
        "gla_norm_w": gain(ks[7], (DEPTH, GLA_HEAD_V)),
        "w_proj_a": normal(ks[8], (DEPTH, HGRN_VAL, D_MODEL), HGRN_VAL ** -0.5),
        "w_proj_b": normal(ks[9], (DEPTH, GLA_VAL, D_MODEL), GLA_VAL ** -0.5),
        "w_out": normal(ks[10], (DEPTH, D_MODEL, D_MODEL), D_MODEL ** -0.5),
        "ffn_norm_w": gain(ks[11], (DEPTH, D_MODEL)),
        "dense_w_gate": normal(ks[12], (N_DENSE, D_MODEL, D_FF_DENSE), D_MODEL ** -0.5),
        "dense_w_up": normal(ks[13], (N_DENSE, D_MODEL, D_FF_DENSE), D_MODEL ** -0.5),
        "dense_w_down": normal(ks[14], (N_DENSE, D_FF_DENSE, D_MODEL), D_FF_DENSE ** -0.5),
        "router_w": normal(ks[15], (N_MOE, D_MODEL, N_EXPERTS), D_MODEL ** -0.5),
        "router_b": normal(ks[16], (N_MOE, N_EXPERTS), 0.01),
        "moe_w_gate": normal(ks[17], (N_MOE, N_EXPERTS, D_MODEL, D_FF_EXPERT), D_MODEL ** -0.5),
        "moe_w_up": normal(ks[18], (N_MOE, N_EXPERTS, D_MODEL, D_FF_EXPERT), D_MODEL ** -0.5),
        "moe_w_down": normal(ks[19], (N_MOE, N_EXPERTS, D_FF_EXPERT, D_MODEL), D_FF_EXPERT ** -0.5),
        "final_norm_w": gain(ks[20], (D_MODEL,)),
    }


def reference(x, mix_norm_w, w_in, lower_bound_logits, gk_up_w, gk_up_b, hgrn_norm_w, gla_norm_w,
              w_proj_a, w_proj_b, w_out, ffn_norm_w, dense_w_gate, dense_w_up, dense_w_down,
              router_w, router_b, moe_w_gate, moe_w_up, moe_w_down, final_norm_w):
    for layer in range(DEPTH):
        h = rms_norm(x, mix_norm_w[layer])
        x = x + hybrid_mixer(h, layer, w_in[layer], lower_bound_logits, gk_up_w[layer], gk_up_b[layer],
                             hgrn_norm_w[layer], gla_norm_w[layer], w_proj_a[layer], w_proj_b[layer],
                             w_out[layer])
        h = rms_norm(x, ffn_norm_w[layer])
        j = layer // 2
        if layer % 2 == 0:
            x = x + swiglu(h, dense_w_gate[j], dense_w_up[j], dense_w_down[j])
        else:
            x = x + moe_swiglu(h, router_w[j], router_b[j], moe_w_gate[j], moe_w_up[j], moe_w_down[j])
    return rms_norm(x, final_norm_w)
```

```cpp
#include <hip/hip_runtime.h>
#include <cstdio>
#include <cstdint>

#define GAS __attribute__((address_space(1)))
#define LAS __attribute__((address_space(3)))
typedef unsigned short bf16;
typedef unsigned v4u __attribute__((ext_vector_type(4)));
typedef unsigned v2u __attribute__((ext_vector_type(2)));
typedef float f32x4 __attribute__((ext_vector_type(4)));
typedef float f32x2 __attribute__((ext_vector_type(2)));
typedef short bf16x8 __attribute__((ext_vector_type(8)));
typedef short s16x4 __attribute__((ext_vector_type(4)));
typedef GAS unsigned gu32;
#define RLX_AGENT __ATOMIC_RELAXED, __HIP_MEMORY_SCOPE_AGENT
#define LDS_WAIT() asm volatile("s_waitcnt lgkmcnt(0)" ::: "memory")
#define VM_WAIT() asm volatile("s_waitcnt vmcnt(0)" ::: "memory")

typedef float f32x2_t __attribute__((ext_vector_type(2)));
typedef __bf16 bf16x2_t __attribute__((ext_vector_type(2)));
__device__ __forceinline__ unsigned cvt_pk_bf16(float lo, float hi) { const f32x2_t v = {lo, hi}; return __builtin_bit_cast(unsigned, __builtin_convertvector(v, bf16x2_t)); }
__device__ __forceinline__ bf16 f2bf(float f) { return (bf16)(cvt_pk_bf16(f, 0.f) & 0xffffu); }
__device__ __forceinline__ float bf2f(bf16 b) { return __uint_as_float(((unsigned)b) << 16); }
__device__ __forceinline__ float bflo(unsigned w) { return __uint_as_float(w << 16); }
__device__ __forceinline__ float bfhi(unsigned w) { return __uint_as_float(w & 0xffff0000u); }
__device__ __forceinline__ float fast_exp(float x) { return __builtin_amdgcn_exp2f(x * 1.4426950408889634f); }
__device__ __forceinline__ float fast_log(float x) { return __builtin_amdgcn_logf(x) * 0.6931471805599453f; }
__device__ __forceinline__ float clampf(float x, float lo, float hi) { return __builtin_fminf(__builtin_fmaxf(x, lo), hi); }
__device__ __forceinline__ float sigmoidf_(float x) { return __builtin_amdgcn_rcpf(1.0f + fast_exp(-clampf(x, -80.f, 80.f))); }
__device__ __forceinline__ float siluf_(float x) { return x * sigmoidf_(x); }
constexpr float NLOG2E = -1.4426950408889634f;
__device__ __forceinline__ unsigned pack4_u8(const f32x4& s) { unsigned w = 0;
    w = __builtin_amdgcn_cvt_pk_u8_f32(__builtin_fmaxf(__builtin_rintf(s[0] * 255.f), 1.f), 0, w); w = __builtin_amdgcn_cvt_pk_u8_f32(__builtin_fmaxf(__builtin_rintf(s[1] * 255.f), 1.f), 1, w);
    w = __builtin_amdgcn_cvt_pk_u8_f32(__builtin_fmaxf(__builtin_rintf(s[2] * 255.f), 1.f), 2, w); w = __builtin_amdgcn_cvt_pk_u8_f32(__builtin_fmaxf(__builtin_rintf(s[3] * 255.f), 1.f), 3, w); return w; }
__device__ __forceinline__ f32x4 unpack4_u8(unsigned w) { return (f32x4){(float)(w & 0xffu), (float)((w >> 8) & 0xffu), (float)((w >> 16) & 0xffu), (float)(w >> 24)}; }
__device__ __forceinline__ float sig_pre(float t) { return __builtin_amdgcn_rcpf(1.0f + __builtin_amdgcn_exp2f(t)); }
__device__ __forceinline__ float wave_sum(float v) {
#pragma unroll
    for (int o = 1; o < 64; o <<= 1) v += __shfl_xor(v, o);
    return v;
}

namespace pg8 {
constexpr int BM = 256, BK = 64, HALF = 128, HTB = HALF * BK * 2  , STAGE_BYTES = 8 * HTB, NXCD = 8, WGM = 8;
__host__ __device__ __forceinline__ int lds_byte(int r, int c) { const int st = (r >> 4) * 2 + (c >> 5), rr = r & 15, cc = c & 31, ob = rr * 64 + cc * 2; return st * 1024 + (ob ^ (((ob >> 9) & 1) << 5)); }
__host__ __device__ __forceinline__ void stage_rc(int b, int& R, int& C) { const int st = b / 1024, sb = b % 1024, swz = sb ^ (((sb >> 9) & 1) << 5); R = (st >> 1) * 16 + swz / 64; C = (st & 1) * 32 + (swz % 64) / 2; }
__host__ __device__ __forceinline__ int perm32(int rho) { const int n = rho >> 4, i = rho & 15; return 8 * (i >> 2) + 4 * n + (i & 3); }

struct Unit { int pm, pn, aux; };

__device__ __forceinline__ bool tile_order(long L, int nM, int nN, int& pm, int& pn) {
    const int nwg = nM * nN; if (L >= nwg) return false;
    int wgid = (int)L; { const int q = nwg / NXCD, r = nwg % NXCD, xcd = wgid % NXCD, off = wgid / NXCD; wgid = (xcd < r ? xcd * (q + 1) : r * (q + 1) + (xcd - r) * q) + off; }
    const int nig = WGM * nN, gid = wgid / nig, fm = gid * WGM, gsz = (nM - fm) < WGM ? (nM - fm) : WGM;
    pm = fm + ((wgid % nig) % gsz); pn = (wgid % nig) / gsz; return true;
}

__device__ __forceinline__ const char* uni_ptr(const char* p) { const unsigned long long v = (unsigned long long)p;
    return (const char*)(((unsigned long long)(unsigned)__builtin_amdgcn_readfirstlane((int)(v >> 32)) << 32) | (unsigned)__builtin_amdgcn_readfirstlane((int)v)); }
__device__ __forceinline__ void glds16_s(const char* sbase, unsigned voff, unsigned lds_addr) {
    unsigned sv;
    asm volatile("s_mov_b32 %0, m0\n\ts_mov_b32 m0, %3\n\ts_nop 0\n\tglobal_load_lds_dwordx4 %1, %2\n\ts_mov_b32 m0, %0" : "=&s"(sv) : "v"(voff), "s"(sbase), "s"(lds_addr) : "memory");
}
typedef f32x4 Acc[2][2][4][2];
typedef int i32x4v __attribute__((ext_vector_type(4)));
typedef int i32x8v __attribute__((ext_vector_type(8)));
__device__ __forceinline__ i32x8v cat8(const bf16x8& a, const bf16x8& b) { return __builtin_shufflevector(__builtin_bit_cast(i32x4v, a), __builtin_bit_cast(i32x4v, b), 0, 1, 2, 3, 4, 5, 6, 7); }
__device__ __forceinline__ void mfma8z(f32x4& acc, const i32x8v& a, const i32x8v& b) { asm volatile("v_mfma_f32_16x16x128_f8f6f4 %0, %1, %2, 0" : "=&v"(acc) : "v"(a), "v"(b)); }
__device__ __forceinline__ void mfma8(f32x4& acc, const i32x8v& a, const i32x8v& b) { asm volatile("v_mfma_f32_16x16x128_f8f6f4 %0, %1, %2, %0" : "+v"(acc) : "v"(a), "v"(b)); }
__device__ __forceinline__ void mfma8_drain(f32x4 (&acc)[2][2][4][2]) {
    asm volatile("s_nop 15\n\ts_nop 15" : "+v"(acc[0][0][0][0]), "+v"(acc[0][0][0][1]), "+v"(acc[0][0][1][0]), "+v"(acc[0][0][1][1]), "+v"(acc[0][0][2][0]), "+v"(acc[0][0][2][1]), "+v"(acc[0][0][3][0]), "+v"(acc[0][0][3][1]),
                 "+v"(acc[0][1][0][0]), "+v"(acc[0][1][0][1]), "+v"(acc[0][1][1][0]), "+v"(acc[0][1][1][1]), "+v"(acc[0][1][2][0]), "+v"(acc[0][1][2][1]), "+v"(acc[0][1][3][0]), "+v"(acc[0][1][3][1]) :: "memory");
    asm volatile("" : "+v"(acc[1][0][0][0]), "+v"(acc[1][0][0][1]), "+v"(acc[1][0][1][0]), "+v"(acc[1][0][1][1]), "+v"(acc[1][0][2][0]), "+v"(acc[1][0][2][1]), "+v"(acc[1][0][3][0]), "+v"(acc[1][0][3][1]),
                 "+v"(acc[1][1][0][0]), "+v"(acc[1][1][0][1]), "+v"(acc[1][1][1][0]), "+v"(acc[1][1][1][1]), "+v"(acc[1][1][2][0]), "+v"(acc[1][1][2][1]), "+v"(acc[1][1][3][0]), "+v"(acc[1][1][3][1]) :: "memory");
}

template <class Epi, class Sched, bool ALIGN_EPI>
__device__ __forceinline__ void gemm_phase(LAS unsigned char* lds, const Sched& S, const Epi& E) {
    int tid_ = threadIdx.x; asm volatile("" : "+v"(tid_));
    const int tid = tid_, wid = __builtin_amdgcn_readfirstlane(tid >> 6), lane = tid & 63, wr = wid >> 2, wc = wid & 3, fr = lane & 15, fq = lane >> 4;
    const int nt = S.KB / 128;
    int Rr[2], Cc[2]; unsigned voffB[2], voffA[2][2], nvoffA[2][2];
#pragma unroll
    for (int i = 0; i < 2; ++i) { stage_rc(tid * 16 + i * 8192, Rr[i], Cc[i]); const int Rb = Epi::PERM ? ((Rr[i] & ~31) + perm32(Rr[i] & 31)) : Rr[i];
        voffB[i] = (unsigned)(Rb * S.ldbB + Cc[i] * 2);
        voffA[0][i] = (unsigned)(Rr[i] * S.ldaB + Cc[i] * 2); voffA[1][i] = (unsigned)((Rr[i] + HALF) * S.ldaB + Cc[i] * 2); nvoffA[0][i] = voffA[0][i]; nvoffA[1][i] = voffA[1][i]; }
    const size_t kstep = (size_t)128;
    const size_t hstepB = (size_t)HALF * S.ldbB;
    const unsigned ldsb = (unsigned)__builtin_amdgcn_readfirstlane((int)((unsigned)(uintptr_t)lds + (unsigned)wid * 1024u));
    const int aoff = lds_byte(wr * 64 + fr, fq * 8), boff = lds_byte(wc * 32 + fr, fq * 8);
#define PG8_SA(b, h) (((b) * 2 + (h)) * HTB)
#define PG8_SB(b, h) ((4 + (b) * 2 + (h)) * HTB)
#define PG8_STAGE(bufoff, gbase, voff) do { _Pragma("unroll") for (int _i = 0; _i < 2; ++_i) glds16_s((gbase), (voff)[_i], ldsb + (unsigned)((bufoff) + _i * 8192)); } while (0)
#define PG8_LDA(dst, b, h) do { _Pragma("unroll") for (int m = 0; m < 4; ++m) _Pragma("unroll") for (int k = 0; k < 2; ++k) dst[m][k] = *(const LAS bf16x8*)(lds + PG8_SA(b, h) + aoff + m * 2048 + k * 1024); } while (0)
#define PG8_LDB(dst, b, h) do { _Pragma("unroll") for (int n = 0; n < 2; ++n) _Pragma("unroll") for (int k = 0; k < 2; ++k) dst[n][k] = *(const LAS bf16x8*)(lds + PG8_SB(b, h) + boff + n * 2048 + k * 1024); } while (0)
#define PG8_MMA(ai, bj, At, Bt) do { __builtin_amdgcn_s_setprio(1); _Pragma("unroll") for (int m = 0; m < 4; ++m) _Pragma("unroll") for (int n = 0; n < 2; ++n) { \
        if constexpr (Sched::FP8) { mfma8(acc[ai][bj][m][n], cat8(Bt[n][0], Bt[n][1]), cat8(At[m][0], At[m][1])); } \
        else { _Pragma("unroll") for (int k = 0; k < 2; ++k) acc[ai][bj][m][n] = __builtin_amdgcn_mfma_f32_16x16x32_bf16(Bt[n][k], At[m][k], acc[ai][bj][m][n], 0, 0, 0); } } \
        __builtin_amdgcn_s_setprio(0); } while (0)
#define PG8_MMA_Z(ai, bj, At, Bt) do { __builtin_amdgcn_s_setprio(1); _Pragma("unroll") for (int m = 0; m < 4; ++m) _Pragma("unroll") for (int n = 0; n < 2; ++n) { \
        if constexpr (Sched::FP8) { mfma8z(acc[ai][bj][m][n], cat8(Bt[n][0], Bt[n][1]), cat8(At[m][0], At[m][1])); } \
        else { acc[ai][bj][m][n] = __builtin_amdgcn_mfma_f32_16x16x32_bf16(Bt[n][0], At[m][0], (f32x4){0.f, 0.f, 0.f, 0.f}, 0, 0, 0); \
               acc[ai][bj][m][n] = __builtin_amdgcn_mfma_f32_16x16x32_bf16(Bt[n][1], At[m][1], acc[ai][bj][m][n], 0, 0, 0); } } \
        __builtin_amdgcn_s_setprio(0); } while (0)
#define PG8_WAIT_V(n) asm volatile("s_waitcnt vmcnt(" #n ")" ::: "memory")
#define PG8_WAIT_L(n) asm volatile("s_waitcnt lgkmcnt(" #n ")" ::: "memory")
#define PG8_BAR __builtin_amdgcn_s_barrier()
#define PG8_SCHED __builtin_amdgcn_sched_barrier(0)
#define PG8_KBODY(t, MMAF) do { \
            const bool last = (t == nt - 2); \
            const char* a1 = cA + (size_t)(t + 1) * kstep; \
            const char* a2 = last ? nA : cA + (size_t)(t + 2) * kstep; const char* b2 = last ? nB : cB + (size_t)(t + 2) * kstep; \
            const char* a3 = a2 + kstep; const char* b3 = b2 + kstep; \
            unsigned o2[2][2]; \
            _Pragma("unroll") \
            for (int h = 0; h < 2; ++h) \
            _Pragma("unroll") \
                for (int i = 0; i < 2; ++i) o2[h][i] = (Sched::GATHER && last) ? nvoffA[h][i] : voffA[h][i]; \
            PG8_LDB(B0, 0, 0); PG8_LDB(B1, 0, 1); PG8_SCHED; PG8_LDA(At, 0, 0); PG8_STAGE(PG8_SA(1, 1), a1, voffA[1]); \
            PG8_WAIT_V(8); PG8_WAIT_L(0); PG8_BAR; MMAF(0, 0, At, B0); MMAF(0, 1, At, B1); PG8_BAR; PG8_SCHED; \
            PG8_LDA(At, 0, 1); PG8_STAGE(PG8_SB(0, 0), b2, voffB); PG8_STAGE(PG8_SB(0, 1), b2 + hstepB, voffB); PG8_STAGE(PG8_SA(0, 0), a2, o2[0]); \
            PG8_WAIT_V(8); PG8_WAIT_L(0); PG8_BAR; MMAF(1, 0, At, B0); MMAF(1, 1, At, B1); PG8_BAR; PG8_SCHED; \
            PG8_LDB(B0, 1, 0); PG8_LDB(B1, 1, 1); PG8_SCHED; PG8_LDA(At, 1, 0); PG8_STAGE(PG8_SA(0, 1), a2, o2[1]); \
            PG8_WAIT_V(8); PG8_WAIT_L(0); PG8_BAR; PG8_MMA(0, 0, At, B0); PG8_MMA(0, 1, At, B1); PG8_BAR; PG8_SCHED; \
            PG8_LDA(At, 1, 1); PG8_STAGE(PG8_SB(1, 0), b3, voffB); PG8_STAGE(PG8_SB(1, 1), b3 + hstepB, voffB); PG8_STAGE(PG8_SA(1, 0), a3, o2[0]); \
            PG8_WAIT_V(8); PG8_WAIT_L(0); PG8_BAR; PG8_MMA(1, 0, At, B0); PG8_MMA(1, 1, At, B1); PG8_BAR; PG8_SCHED; \
        } while (0)
    Unit cur, nxt; int ui = 0;
    if (!S.next(0, cur)) return;
    Acc acc;
#pragma unroll
    for (int a = 0; a < 2; ++a)
#pragma unroll
        for (int b = 0; b < 2; ++b)
#pragma unroll
            for (int m = 0; m < 4; ++m)
#pragma unroll
                for (int n = 0; n < 2; ++n) acc[a][b][m][n] = (f32x4){0.f, 0.f, 0.f, 0.f};
    bf16x8 At[4][2], B0[2][2], B1[2][2];
    const char* cA = uni_ptr(S.a_base(cur)); const char* cB = uni_ptr(S.b_base(cur));
    int tkn[2][2] = {{0, 0}, {0, 0}}; Unit un2;
    if constexpr (Sched::GATHER) { S.a_offs(cur, Rr, Cc, voffA); if (!S.next(1, un2)) un2 = cur; S.a_idx(un2, Rr, tkn); }
    PG8_STAGE(PG8_SB(0, 0), cB, voffB); PG8_STAGE(PG8_SB(0, 1), cB + hstepB, voffB); PG8_STAGE(PG8_SA(0, 0), cA, voffA[0]); PG8_STAGE(PG8_SA(0, 1), cA, voffA[1]);
    if (wr == 1) PG8_BAR;
    PG8_WAIT_V(2); PG8_BAR;
    PG8_STAGE(PG8_SB(1, 0), cB + kstep, voffB); PG8_STAGE(PG8_SA(1, 0), cA + kstep, voffA[0]); PG8_STAGE(PG8_SB(1, 1), cB + hstepB + kstep, voffB);
    PG8_WAIT_V(6); PG8_BAR;
    for (;;) {
        const bool has_next = S.next(ui + 1, nxt);
        const char* nA = uni_ptr(has_next ? S.a_base(nxt) : cA); const char* nB = uni_ptr(has_next ? S.b_base(nxt) : cB);
        if constexpr (Sched::GATHER) { if (has_next) { S.a_fin(nxt, Rr, Cc, tkn, nvoffA); if (!S.next(ui + 2, un2)) un2 = nxt; S.a_idx(un2, Rr, tkn); } else {
#pragma unroll
            for (int i = 0; i < 2; ++i) { nvoffA[0][i] = voffA[0][i]; nvoffA[1][i] = voffA[1][i]; } } }
        if constexpr (Epi::ZERO_RESET) { PG8_KBODY(0, PG8_MMA_Z); for (int t = 2; t < nt; t += 2) PG8_KBODY(t, PG8_MMA); }
        else { for (int t = 0; t < nt; t += 2) PG8_KBODY(t, PG8_MMA); }
        if constexpr (Sched::FP8) mfma8_drain(acc);
        if constexpr (ALIGN_EPI) { if (wr == 0) PG8_BAR; }
        {
          int tz = threadIdx.x; asm volatile("" : "+v"(tz)); const int wz = __builtin_amdgcn_readfirstlane(tz >> 6), lz = tz & 63;
          if (!S.skip_epi) E(acc, cur, wz >> 2, wz & 3, lz & 15, lz >> 4);
          if (!has_next) break;
          if constexpr (!Epi::ZERO_RESET) E.reset(acc, cur, wz >> 2, wz & 3, lz & 15, lz >> 4); }
        cur = nxt; cA = nA; cB = nB; ++ui;
        if constexpr (Sched::GATHER) {
#pragma unroll
            for (int i = 0; i < 2; ++i) { voffA[0][i] = nvoffA[0][i]; voffA[1][i] = nvoffA[1][i]; } }
        if constexpr (ALIGN_EPI) { if (wr == 1) PG8_BAR; }
    }
    PG8_WAIT_V(0);
    if constexpr (!ALIGN_EPI) { if (wr == 0) PG8_BAR; }
    PG8_BAR;
#undef PG8_KBODY
#undef PG8_MMA_Z
#undef PG8_SA
#undef PG8_SB
#undef PG8_STAGE
#undef PG8_LDA
#undef PG8_LDB
#undef PG8_MMA
#undef PG8_WAIT_V
#undef PG8_WAIT_L
#undef PG8_BAR
#undef PG8_SCHED
}
}
constexpr int T = 8192, D = 2048, DEPTH = 2;
constexpr int NIN_BF = 30;
constexpr int NIN = 11776;
constexpr int DIN_SRC = 11280;
constexpr int DFF = 5632, DFFE = 7168, NE = 8;
constexpr int QK_LD = 1536, V_LD = 2048, M_LD = 4096;
constexpr int NCH = 128, CH = 64, NHEADS = 12;
constexpr int STATE_E = 262144;
constexpr float EPS = 1e-6f;
constexpr float QSCALE = 0.08838834764831845f;
constexpr int MOE_CAP = 8192;
constexpr int MOE_MAXT = 72;

template <bool F8> struct SchedDenseT {
    static constexpr bool GATHER = false, FP8 = F8;
    const char* A; const char* Bt; int nM, nN, G, c, ldaB, ldbB, KB, skip_epi;
    __device__ __forceinline__ void shape(int lda, int K) { const int es = F8 ? 1 : 2; ldaB = lda * es; ldbB = K * es; KB = K * es; }
    __device__ __forceinline__ bool next(int i, pg8::Unit& u) const { u.aux = 0; return pg8::tile_order((long)i * G + c, nM, nN, u.pm, u.pn); }
    __device__ __forceinline__ const char* a_base(const pg8::Unit& u) const { return A + (size_t)u.pm * 256 * ldaB; }
    __device__ __forceinline__ const char* b_base(const pg8::Unit& u) const { return Bt + (size_t)u.pn * 256 * ldbB; }
    __device__ __forceinline__ void a_offs(const pg8::Unit&, const int (&)[2], const int (&)[2], unsigned (&)[2][2]) const {}
};
typedef SchedDenseT<false> SchedDense;
typedef SchedDenseT<true> SchedDense8;
struct SchedProj {
    static constexpr bool GATHER = false, FP8 = false;
    const char* Y; const char* Wa; const char* Wb; int G, c, ldaB, ldbB, KB, skip_epi;
    __device__ __forceinline__ bool next(int i, pg8::Unit& u) const { u.aux = i & 1; return pg8::tile_order((long)(i >> 1) * G + c, T / 256, D / 256, u.pm, u.pn); }
    __device__ __forceinline__ const char* a_base(const pg8::Unit& u) const { return Y + (size_t)u.pm * 256 * ldaB + (u.aux ? 1024 * 2 : 0); }
    __device__ __forceinline__ const char* b_base(const pg8::Unit& u) const { return (u.aux ? Wb : Wa) + (size_t)u.pn * 256 * ldbB; }
    __device__ __forceinline__ void a_offs(const pg8::Unit&, const int (&)[2], const int (&)[2], unsigned (&)[2][2]) const {}
};
typedef int i32x8 __attribute__((ext_vector_type(8)));
struct MoeTiles {
    i32x8 cnt, tb; int ntiles;
    __device__ __forceinline__ void load(const unsigned* counts_) {
        int s = 0;
#pragma unroll
        for (int e = 0; e < NE; ++e) { int c = (int)__hip_atomic_load((unsigned*)counts_ + e, RLX_AGENT); c = c < 0 ? 0 : (c > MOE_CAP ? MOE_CAP : c); c = __builtin_amdgcn_readfirstlane(c); cnt[e] = c; tb[e] = s; s += (c + 255) >> 8; }
        ntiles = s;
    }
    __device__ __forceinline__ int expert_of(int pm) const {
        return (pm >= tb[1] ? 1 : 0) + (pm >= tb[2] ? 1 : 0) + (pm >= tb[3] ? 1 : 0) + (pm >= tb[4] ? 1 : 0) + (pm >= tb[5] ? 1 : 0) + (pm >= tb[6] ? 1 : 0) + (pm >= tb[7] ? 1 : 0); }
    __device__ __forceinline__ int cnt_of(int e) const { int c = cnt[0]; c = e == 1 ? cnt[1] : c; c = e == 2 ? cnt[2] : c; c = e == 3 ? cnt[3] : c; c = e == 4 ? cnt[4] : c; c = e == 5 ? cnt[5] : c; c = e == 6 ? cnt[6] : c; c = e == 7 ? cnt[7] : c; return c; }
    __device__ __forceinline__ int tb_of(int e) const { int c = tb[0]; c = e == 1 ? tb[1] : c; c = e == 2 ? tb[2] : c; c = e == 3 ? tb[3] : c; c = e == 4 ? tb[4] : c; c = e == 5 ? tb[5] : c; c = e == 6 ? tb[6] : c; c = e == 7 ? tb[7] : c; return c; }
};
struct SchedMoeGU {
    static constexpr bool GATHER = true, FP8 = true;
    const char* X8; const char* W; const int* list; MoeTiles mt; int G, c, ldaB, ldbB, KB, skip_epi;
    __device__ __forceinline__ bool next(int i, pg8::Unit& u) const {
        if (!pg8::tile_order((long)i * G + c, mt.ntiles, (2 * DFFE) / 256, u.pm, u.pn)) return false;
        const int e = mt.expert_of(u.pm); u.aux = e | ((u.pm - mt.tb_of(e)) << 8); return true; }
    __device__ __forceinline__ const char* a_base(const pg8::Unit&) const { return X8; }
    __device__ __forceinline__ const char* b_base(const pg8::Unit& u) const { return W + (size_t)(u.aux & 255) * ((size_t)2 * DFFE * D) + (size_t)u.pn * 256 * ldbB; }
    __device__ __forceinline__ void a_idx(const pg8::Unit& u, const int (&R)[2], int (&tk)[2][2]) const {
        const int e = u.aux & 255, lt = u.aux >> 8, n = mt.cnt_of(e);
#pragma unroll
        for (int h = 0; h < 2; ++h)
#pragma unroll
            for (int i = 0; i < 2; ++i) { const int pos = lt * 256 + h * 128 + R[i]; tk[h][i] = list[e * MOE_CAP + (pos < n ? pos : 0)]; }
    }
    __device__ __forceinline__ void a_fin(const pg8::Unit& u, const int (&R)[2], const int (&C)[2], const int (&tk)[2][2], unsigned (&voff)[2][2]) const {
        const int e = u.aux & 255, lt = u.aux >> 8, n = mt.cnt_of(e);
#pragma unroll
        for (int h = 0; h < 2; ++h)
#pragma unroll
            for (int i = 0; i < 2; ++i) { const int pos = lt * 256 + h * 128 + R[i]; const int tok = pos < n ? tk[h][i] : 0; voff[h][i] = (unsigned)(tok * D + C[i] * 2); }
    }
    __device__ __forceinline__ void a_offs(const pg8::Unit& u, const int (&R)[2], const int (&C)[2], unsigned (&voff)[2][2]) const { int tk[2][2]; a_idx(u, R, tk); a_fin(u, R, C, tk, voff); }
};
struct SchedMoeDN {
    static constexpr bool GATHER = false, FP8 = true;
    const char* A; const char* W; MoeTiles mt; int G, c, ldaB, ldbB, KB, skip_epi;
    __device__ __forceinline__ bool next(int i, pg8::Unit& u) const {
        int pn2; if (!pg8::tile_order((long)i * G + c, mt.ntiles, 2 * (D / 256), u.pm, pn2)) return false;
        u.pn = pn2 >> 1; u.aux = mt.expert_of(u.pm) | ((pn2 & 1) << 8); return true; }
    __device__ __forceinline__ const char* a_base(const pg8::Unit& u) const { return A + (size_t)u.pm * 256 * ldaB + (size_t)(u.aux >> 8) * KB; }
    __device__ __forceinline__ const char* b_base(const pg8::Unit& u) const { return W + (size_t)(u.aux & 255) * ((size_t)D * DFFE) + (size_t)u.pn * 256 * ldbB + (size_t)(u.aux >> 8) * KB; }
    __device__ __forceinline__ void a_offs(const pg8::Unit&, const int (&)[2], const int (&)[2], unsigned (&)[2][2]) const {}
};

__device__ __forceinline__ void acc_zero(pg8::Acc& acc) {
#pragma unroll
    for (int a = 0; a < 2; ++a)
#pragma unroll
        for (int b = 0; b < 2; ++b)
#pragma unroll
            for (int m = 0; m < 4; ++m)
#pragma unroll
                for (int n = 0; n < 2; ++n) acc[a][b][m][n] = (f32x4){0.f, 0.f, 0.f, 0.f};
}
__device__ __forceinline__ v4u pack8(const f32x4& a, const f32x4& b) { v4u w; w.x = cvt_pk_bf16(a[0], a[1]); w.y = cvt_pk_bf16(a[2], a[3]); w.z = cvt_pk_bf16(b[0], b[1]); w.w = cvt_pk_bf16(b[2], b[3]); return w; }

__device__ __forceinline__ float row_scale(const float* rsp, size_t row) {
    const f32x4 a = *(const f32x4*)(rsp + row * 8), b = *(const f32x4*)(rsp + row * 8 + 4);
    return __builtin_amdgcn_rsqf((((a[0] + a[1]) + (a[2] + a[3])) + ((b[0] + b[1]) + (b[2] + b[3]))) * (1.0f / D) + EPS);
}
constexpr float W8_SCALE = 64.f, ACT8_SCALE = 16.f;
__device__ __forceinline__ float clamp8(float x) { return __builtin_fminf(__builtin_fmaxf(x, -448.f), 448.f); }
__device__ __forceinline__ unsigned pack4_fp8(float a, float b, float c, float d) { int w = 0; w = __builtin_amdgcn_cvt_pk_fp8_f32(clamp8(a), clamp8(b), w, false); w = __builtin_amdgcn_cvt_pk_fp8_f32(clamp8(c), clamp8(d), w, true); return (unsigned)w; }
constexpr float X8_SCALE = 4.f;
struct RowScales { float v[8]; };
__device__ __forceinline__ void row_scales8(RowScales& R, const float* rsp, int row0) {
#pragma unroll
    for (int h = 0; h < 2; ++h) { f32x4 a[4], b[4];
#pragma unroll
        for (int g = 0; g < 4; ++g) { const size_t row = (size_t)(row0 + h * 128 + g * 16); a[g] = *(const f32x4*)(rsp + row * 8); b[g] = *(const f32x4*)(rsp + row * 8 + 4); }
#pragma unroll
        for (int g = 0; g < 4; ++g) R.v[4 * h + g] = __builtin_amdgcn_rsqf((((a[g][0] + a[g][1]) + (a[g][2] + a[g][3])) + ((b[g][0] + b[g][1]) + (b[g][2] + b[g][3]))) * (1.0f / D) + EPS);
        asm volatile("" ::: "memory"); }
}
struct EpiIn {
    static constexpr bool PERM = true, ZERO_RESET = false;
    const float* rsq;
    bf16 *Q, *Kb, *V, *SG, *M; float* Gf; const float* lbv; const float* gkb;
    __device__ __forceinline__ void operator()(const pg8::Acc& acc, const pg8::Unit& u, int wr, int wc, int fr, int fq) const {
        const int pn = u.pn, row0 = u.pm * 256 + wr * 64 + fr, cl = wc * 32 + 8 * fq;
        int mode, ld, col0; int sel; float sc = 1.f;
        if (pn < 4)       { mode = 0; sel = 0; ld = QK_LD; col0 = 256 * pn; sc = QSCALE; }
        else if (pn < 8)  { mode = 3; sel = 1; ld = QK_LD; col0 = 256 * (pn - 4); }
        else if (pn < 12) { mode = 0; sel = 2; ld = V_LD;  col0 = 256 * (pn - 8); }
        else if (pn < 16) { mode = 1; sel = 3; ld = V_LD;  col0 = 256 * (pn - 12); }
        else if (pn < 18) { mode = 0; sel = 0; ld = QK_LD; col0 = 1024 + 256 * (pn - 16); sc = QSCALE; }
        else if (pn < 20) { mode = 0; sel = 1; ld = QK_LD; col0 = 1024 + 256 * (pn - 18); }
        else if (pn < 24) { mode = 0; sel = 2; ld = V_LD;  col0 = 1024 + 256 * (pn - 20); }
        else if (pn < 28) { mode = 1; sel = 3; ld = V_LD;  col0 = 1024 + 256 * (pn - 24); }
        else              { mode = 4; sel = 0; ld = QK_LD; col0 = 1024 + 256 * (pn - 28); }
        const size_t doff = sel == 0 ? (size_t)0 : sel == 1 ? (size_t)((const char*)Kb - (const char*)Q) : sel == 2 ? (size_t)((const char*)V - (const char*)Q) : (size_t)((const char*)SG - (const char*)Q);
        bf16* dst = (bf16*)((char*)Q + doff);
        RowScales RS; row_scales8(RS, rsq, row0);
#define RS_AT(ai, m) RS.v[(ai) * 4 + (m)]
        if (mode <= 1) {
#pragma unroll
            for (int ai = 0; ai < 2; ++ai)
#pragma unroll
                for (int m = 0; m < 4; ++m) { const float r = RS_AT(ai, m) * sc, nr = r * NLOG2E; bf16* rowp = dst + (size_t)(row0 + ai * 128 + m * 16) * ld + col0 + cl;
#pragma unroll
                    for (int bj = 0; bj < 2; ++bj) { f32x4 v0 = acc[ai][bj][m][0] * r, v1 = acc[ai][bj][m][1] * r;
                        if (mode == 1) { const f32x4 t0 = acc[ai][bj][m][0] * nr, t1 = acc[ai][bj][m][1] * nr;
#pragma unroll
                            for (int j = 0; j < 4; ++j) { v0[j] *= sig_pre(t0[j]); v1[j] *= sig_pre(t1[j]); } }
                        *(v4u*)(rowp + bj * 128) = pack8(v0, v1); } }
        } else if (mode == 3) {
#pragma unroll
            for (int bj = 0; bj < 2; ++bj) {
                const f32x4 lb0 = *(const f32x4*)(lbv + col0 + bj * 128 + cl), lb1 = *(const f32x4*)(lbv + col0 + bj * 128 + cl + 4); const f32x4 om0 = 1.f - lb0, om1 = 1.f - lb1;
#pragma unroll
                for (int ai = 0; ai < 2; ++ai)
#pragma unroll
                    for (int m = 0; m < 4; ++m) { const float nr = RS_AT(ai, m) * NLOG2E; const size_t ro = (size_t)(row0 + ai * 128 + m * 16) * QK_LD + col0 + bj * 128 + cl;
                        f32x4 g0, g1, k0, k1;
#pragma unroll
                        for (int j = 0; j < 4; ++j) {
                            { const float t = __builtin_amdgcn_exp2f(clampf(acc[ai][bj][m][0][j] * nr, -115.f, 115.f)), s = __builtin_amdgcn_rcpf(1.f + t), om = om0[j]; g0[j] = fast_log(__builtin_fmaf(om, s, lb0[j])); k0[j] = __builtin_fmaf(-om, s, om); }
                            { const float t = __builtin_amdgcn_exp2f(clampf(acc[ai][bj][m][1][j] * nr, -115.f, 115.f)), s = __builtin_amdgcn_rcpf(1.f + t), om = om1[j]; g1[j] = fast_log(__builtin_fmaf(om, s, lb1[j])); k1[j] = __builtin_fmaf(-om, s, om); } }
                        *(f32x4*)(Gf + ro) = g0; *(f32x4*)(Gf + ro + 4) = g1; *(v4u*)(Kb + ro) = pack8(k0, k1); } }
        } else {
#pragma unroll
            for (int bj = 0; bj < 2; ++bj) {
                const f32x4 b0 = *(const f32x4*)(gkb + (col0 - 1024) + bj * 128 + cl), b1 = *(const f32x4*)(gkb + (col0 - 1024) + bj * 128 + cl + 4);
#pragma unroll
                for (int ai = 0; ai < 2; ++ai)
#pragma unroll
                    for (int m = 0; m < 4; ++m) { const float r = RS_AT(ai, m); const size_t ro = (size_t)(row0 + ai * 128 + m * 16) * QK_LD + col0 + bj * 128 + cl;
                        f32x4 g0, g1;
#pragma unroll
                        for (int j = 0; j < 4; ++j) {
                            { const float z = clampf(acc[ai][bj][m][0][j] * r + b0[j], -80.f, 80.f); g0[j] = -fast_log(1.f + fast_exp(-z)) * (1.f / 16.f); }
                            { const float z = clampf(acc[ai][bj][m][1][j] * r + b1[j], -80.f, 80.f); g1[j] = -fast_log(1.f + fast_exp(-z)) * (1.f / 16.f); } }
                        *(f32x4*)(Gf + ro) = g0; *(f32x4*)(Gf + ro + 4) = g1; } }
        }
    }
    __device__ __forceinline__ void reset(pg8::Acc& acc, const pg8::Unit&, int, int, int, int) const { acc_zero(acc); }
};

struct EpiIn8 {
    static constexpr bool PERM = true, ZERO_RESET = false;
    const float* rsq; unsigned char* M;
    __device__ __forceinline__ void operator()(const pg8::Acc& acc, const pg8::Unit& u, int wr, int wc, int fr, int fq) const {
        const int row0 = u.pm * 256 + wr * 64 + fr, col0 = u.pn * 256 + wc * 32 + 8 * fq;
        RowScales RS; row_scales8(RS, rsq, row0);
#pragma unroll
        for (int ai = 0; ai < 2; ++ai)
#pragma unroll
            for (int m = 0; m < 4; ++m) { const size_t r = (size_t)(row0 + ai * 128 + m * 16); const float rs = RS.v[ai * 4 + m] * (NLOG2E / (W8_SCALE * X8_SCALE));
#pragma unroll
                for (int bj = 0; bj < 2; ++bj) { f32x4 v0 = acc[ai][bj][m][0] * rs, v1 = acc[ai][bj][m][1] * rs;
#pragma unroll
                    for (int j = 0; j < 4; ++j) { v0[j] = sig_pre(v0[j]); v1[j] = sig_pre(v1[j]); }
                    v2u w; w.x = pack4_u8(v0); w.y = pack4_u8(v1); *(v2u*)(M + r * M_LD + col0 + bj * 128) = w; }
                asm volatile("" ::: "memory"); }
    }
    __device__ __forceinline__ void reset(pg8::Acc& acc, const pg8::Unit&, int, int, int, int) const { acc_zero(acc); }
};
struct EpiProj {
    static constexpr bool PERM = true, ZERO_RESET = false;
    const unsigned char* M; bf16* MG;
    __device__ __forceinline__ void operator()(const pg8::Acc& acc, const pg8::Unit& u, int wr, int wc, int fr, int fq) const {
        if (u.aux == 0) return;
        const int row0 = u.pm * 256 + wr * 64 + fr, col0 = u.pn * 256 + wc * 32 + 8 * fq;
        v2u ngb[2], ngb2[2];
#pragma unroll
        for (int bj = 0; bj < 2; ++bj) { ngb[bj] = *(const v2u*)(M + (size_t)row0 * M_LD + 2048 + col0 + bj * 128); ngb2[bj] = *(const v2u*)(M + (size_t)(row0 + 16) * M_LD + 2048 + col0 + bj * 128); }
#pragma unroll
        for (int ai = 0; ai < 2; ++ai)
#pragma unroll
            for (int m = 0; m < 4; ++m) { const size_t r = (size_t)(row0 + ai * 128 + m * 16);
                v2u cgb[2]; cgb[0] = ngb[0]; cgb[1] = ngb[1]; ngb[0] = ngb2[0]; ngb[1] = ngb2[1];
                if (ai * 4 + m < 6) { const int gn = ai * 4 + m + 2; const size_t rn = (size_t)(row0 + (gn >> 2) * 128 + (gn & 3) * 16);
#pragma unroll
                    for (int bj = 0; bj < 2; ++bj) ngb2[bj] = *(const v2u*)(M + rn * M_LD + 2048 + col0 + bj * 128); }
#pragma unroll
                for (int bj = 0; bj < 2; ++bj) { const v2u gb = cgb[bj];
                    const f32x4 v0 = acc[ai][bj][m][0] * unpack4_u8(gb.x) * (1.0f / 255.f), v1 = acc[ai][bj][m][1] * unpack4_u8(gb.y) * (1.0f / 255.f);
                    *(v4u*)(MG + r * D + col0 + bj * 128) = pack8(v0, v1); }
                asm volatile("" ::: "memory"); }
    }
    __device__ __forceinline__ void reset(pg8::Acc& acc, const pg8::Unit& u, int wr, int wc, int fr, int fq) const {
        const float keep = u.aux == 0 ? 1.f : 0.f;
        const int row0 = u.pm * 256 + wr * 64 + fr, col0 = u.pn * 256 + wc * 32 + 8 * fq;
        v2u nga[2], ngb[2], nga2[2], ngb2[2];
#pragma unroll
        for (int bj = 0; bj < 2; ++bj) { nga[bj] = *(const v2u*)(M + (size_t)row0 * M_LD + col0 + bj * 128); ngb[bj] = *(const v2u*)(M + (size_t)row0 * M_LD + 2048 + col0 + bj * 128);
            nga2[bj] = *(const v2u*)(M + (size_t)(row0 + 16) * M_LD + col0 + bj * 128); ngb2[bj] = *(const v2u*)(M + (size_t)(row0 + 16) * M_LD + 2048 + col0 + bj * 128); }
#pragma unroll
        for (int ai = 0; ai < 2; ++ai)
#pragma unroll
            for (int m = 0; m < 4; ++m) {
                v2u cga[2], cgb[2]; cga[0] = nga[0]; cga[1] = nga[1]; cgb[0] = ngb[0]; cgb[1] = ngb[1]; nga[0] = nga2[0]; nga[1] = nga2[1]; ngb[0] = ngb2[0]; ngb[1] = ngb2[1];
                if (ai * 4 + m < 6) { const int gn = ai * 4 + m + 2; const size_t rn = (size_t)(row0 + (gn >> 2) * 128 + (gn & 3) * 16);
#pragma unroll
                    for (int bj = 0; bj < 2; ++bj) { nga2[bj] = *(const v2u*)(M + rn * M_LD + col0 + bj * 128); ngb2[bj] = *(const v2u*)(M + rn * M_LD + 2048 + col0 + bj * 128); } }
#pragma unroll
                for (int bj = 0; bj < 2; ++bj) { const f32x4 a0 = unpack4_u8(cga[bj].x), a1 = unpack4_u8(cga[bj].y), b0 = unpack4_u8(cgb[bj].x), b1 = unpack4_u8(cgb[bj].y);
#pragma unroll
                    for (int j = 0; j < 4; ++j) { acc[ai][bj][m][0][j] *= keep * a0[j] * __builtin_amdgcn_rcpf(b0[j]); acc[ai][bj][m][1][j] *= keep * a1[j] * __builtin_amdgcn_rcpf(b1[j]); } }
                asm volatile("" : "+v"(acc[ai][0][m][0]), "+v"(acc[ai][0][m][1]), "+v"(acc[ai][1][m][0]), "+v"(acc[ai][1][m][1]));
                asm volatile("" ::: "memory"); }
    }
};

struct EpiRes {
    static constexpr bool PERM = true, ZERO_RESET = false;
    bf16* xb; float* rsp_out; LAS float* part;
    unsigned char* x8;
    __device__ __forceinline__ void operator()(const pg8::Acc& acc, const pg8::Unit& u, int wr, int wc, int fr, int fq) const {
        const int row0 = u.pm * 256 + wr * 64 + fr, col0 = u.pn * 256 + wc * 32 + 8 * fq;
        v4u nx[2], nx2[2];
#pragma unroll
        for (int bj = 0; bj < 2; ++bj) { nx[bj] = *(const v4u*)(xb + (size_t)row0 * D + col0 + bj * 128); nx2[bj] = *(const v4u*)(xb + (size_t)(row0 + 16) * D + col0 + bj * 128); }
#pragma unroll
        for (int ai = 0; ai < 2; ++ai)
#pragma unroll
            for (int m = 0; m < 4; ++m) { const size_t r = (size_t)(row0 + ai * 128 + m * 16); float ss = 0.f;
                v4u cx[2];
#pragma unroll
                for (int q = 0; q < 2; ++q) { cx[q] = nx[q]; nx[q] = nx2[q]; }
                if (ai * 4 + m < 6) { const int gn = ai * 4 + m + 2; const size_t rn = (size_t)(row0 + (gn >> 2) * 128 + (gn & 3) * 16);
#pragma unroll
                    for (int bj = 0; bj < 2; ++bj) nx2[bj] = *(const v4u*)(xb + rn * D + col0 + bj * 128); }
#pragma unroll
                for (int bj = 0; bj < 2; ++bj) { const size_t o = r * D + col0 + bj * 128; const v4u c = cx[bj];
                    const f32x4 x0 = (f32x4){bflo(c.x), bfhi(c.x), bflo(c.y), bfhi(c.y)} + acc[ai][bj][m][0], x1 = (f32x4){bflo(c.z), bfhi(c.z), bflo(c.w), bfhi(c.w)} + acc[ai][bj][m][1];
                    *(v4u*)(xb + o) = pack8(x0, x1);
                    if (x8) { v2u w; w.x = pack4_fp8(x0[0] * X8_SCALE, x0[1] * X8_SCALE, x0[2] * X8_SCALE, x0[3] * X8_SCALE); w.y = pack4_fp8(x1[0] * X8_SCALE, x1[1] * X8_SCALE, x1[2] * X8_SCALE, x1[3] * X8_SCALE); *(v2u*)(x8 + o) = w; }
                    ss += (x0[0] * x0[0] + x0[1] * x0[1]) + (x0[2] * x0[2] + x0[3] * x0[3]) + (x1[0] * x1[0] + x1[1] * x1[1]) + (x1[2] * x1[2] + x1[3] * x1[3]); }
                ss += __shfl_xor(ss, 16); ss += __shfl_xor(ss, 32);
                if (fq == 0) part[(wr * 64 + fr + ai * 128 + m * 16) * 4 + wc] = ss;
                asm volatile("" ::: "memory"); }
        asm volatile("s_waitcnt lgkmcnt(0)" ::: "memory"); __builtin_amdgcn_s_barrier(); asm volatile("" ::: "memory");
        const int t = (wr * 4 + wc) * 64 + fq * 16 + fr;
        if (t < 256) { const f32x4 p = *(const LAS f32x4*)(part + t * 4); rsp_out[(size_t)(u.pm * 256 + t) * 8 + u.pn] = (p[0] + p[1]) + (p[2] + p[3]); }
    }
    __device__ __forceinline__ void reset(pg8::Acc& acc, const pg8::Unit&, int, int, int, int) const { acc_zero(acc); }
};

struct EpiGU {
    static constexpr bool PERM = true, ZERO_RESET = false;
    const float* rsq; bf16* H; int ldh;
    __device__ __forceinline__ void operator()(const pg8::Acc& acc, const pg8::Unit& u, int wr, int wc, int fr, int fq) const {
        const int row0 = u.pm * 256 + wr * 64 + fr, col0 = u.pn * 128 + wc * 32 + 8 * fq;
        RowScales RS; row_scales8(RS, rsq, row0);
#pragma unroll
        for (int ai = 0; ai < 2; ++ai)
#pragma unroll
            for (int m = 0; m < 4; ++m) { const size_t r = (size_t)(row0 + ai * 128 + m * 16); const float rs = RS.v[ai * 4 + m], nr = rs * NLOG2E, r2 = rs * rs;
                const f32x4 t0 = acc[ai][0][m][0] * nr, t1 = acc[ai][0][m][1] * nr;
                f32x4 h0 = acc[ai][0][m][0] * acc[ai][1][m][0] * r2, h1 = acc[ai][0][m][1] * acc[ai][1][m][1] * r2;
#pragma unroll
                for (int j = 0; j < 4; ++j) { h0[j] *= sig_pre(t0[j]); h1[j] *= sig_pre(t1[j]); }
                *(v4u*)(H + r * ldh + col0) = pack8(h0, h1); }
    }
    __device__ __forceinline__ void reset(pg8::Acc& acc, const pg8::Unit&, int, int, int, int) const { acc_zero(acc); }
};
struct EpiGUMoe {
    static constexpr bool PERM = true, ZERO_RESET = true;
    unsigned char* ACT8; MoeTiles mt;
    __device__ __forceinline__ void operator()(const pg8::Acc& acc, const pg8::Unit& u, int wr, int wc, int fr, int fq) const {
        const int e = u.aux & 255, lt = u.aux >> 8, n = mt.cnt_of(e);
        const int rl0 = wr * 64 + fr, col0 = u.pn * 128 + wc * 32 + 8 * fq;
#pragma unroll
        for (int ai = 0; ai < 2; ++ai)
#pragma unroll
            for (int m = 0; m < 4; ++m) { const int rl = rl0 + ai * 128 + m * 16, pos = lt * 256 + rl; const float sg = (1.0f / W8_SCALE), su = pos < n ? (ACT8_SCALE / W8_SCALE) * sg : 0.f;
                const f32x4 t0 = acc[ai][0][m][0] * (NLOG2E * sg), t1 = acc[ai][0][m][1] * (NLOG2E * sg);
                f32x4 h0 = acc[ai][0][m][0] * acc[ai][1][m][0] * su, h1 = acc[ai][0][m][1] * acc[ai][1][m][1] * su;
#pragma unroll
                for (int j = 0; j < 4; ++j) { h0[j] *= sig_pre(t0[j]); h1[j] *= sig_pre(t1[j]); }
                v2u w; w.x = pack4_fp8(h0[0], h0[1], h0[2], h0[3]); w.y = pack4_fp8(h1[0], h1[1], h1[2], h1[3]);
                *(v2u*)(ACT8 + (size_t)(u.pm * 256 + rl) * DFFE + col0) = w; }
    }
    __device__ __forceinline__ void reset(pg8::Acc& acc, const pg8::Unit&, int, int, int, int) const { acc_zero(acc); }
};
struct EpiDnMoe {
    static constexpr bool PERM = true, ZERO_RESET = true;
    bf16* YP;
    __device__ __forceinline__ void operator()(const pg8::Acc& acc, const pg8::Unit& u, int wr, int wc, int fr, int fq) const {
        const int row0 = u.pm * 256 + wr * 64 + fr, col0 = u.pn * 256 + wc * 32 + 8 * fq; bf16* yp = YP + (size_t)(u.aux >> 8) * ((size_t)MOE_MAXT * 256 * D);
        const float sc = 1.0f / (W8_SCALE * ACT8_SCALE);
#pragma unroll
        for (int ai = 0; ai < 2; ++ai)
#pragma unroll
            for (int m = 0; m < 4; ++m) { const size_t r = (size_t)(row0 + ai * 128 + m * 16);
#pragma unroll
                for (int bj = 0; bj < 2; ++bj) *(v4u*)(yp + r * D + col0 + bj * 128) = pack8(acc[ai][bj][m][0] * sc, acc[ai][bj][m][1] * sc); }
    }
    __device__ __forceinline__ void reset(pg8::Acc& acc, const pg8::Unit&, int, int, int, int) const { acc_zero(acc); }
};
constexpr size_t MiB = 1u << 20;
constexpr size_t WS_CTL = 0, CTL_ZERO_BYTES = 1 * MiB;
constexpr size_t WS_SMALL = 1 * MiB;
constexpr size_t WS_LBV = WS_SMALL;
constexpr size_t WS_LIST = WS_SMALL + 64 * 1024;
constexpr size_t WS_RSL = WS_LIST + 256 * 1024;
constexpr size_t WS_TSLOT = WS_RSL + 256 * 1024;
constexpr size_t WS_TW = WS_TSLOT + 64 * 1024;
constexpr size_t WS_DEC = 2 * MiB;
constexpr size_t WS_ER = 3 * MiB;
constexpr size_t WS_RSP = 4 * MiB;
constexpr size_t WS_WIN = 8 * MiB;
constexpr size_t WS_WPA = WS_WIN + 92 * MiB;
constexpr size_t WS_WPB = WS_WPA + 8 * MiB;
constexpr size_t WS_WOUT = WS_WPB + 8 * MiB;
constexpr size_t WS_WGU0 = WS_WOUT + 16 * MiB;
constexpr size_t WS_WD0 = WS_WGU0 + 44 * MiB;
constexpr size_t WS_WGUE = WS_WD0 + 22 * MiB;
constexpr size_t WS_WDE = WS_WGUE + 224 * MiB;
constexpr size_t WS_WIN8 = WS_WDE + 112 * MiB;
constexpr size_t WS_XB8 = WS_WIN8 + 16 * MiB;
constexpr size_t WS_XA = WS_XB8 + 16 * MiB;
constexpr size_t WS_XB = WS_XA + 64 * MiB;
constexpr size_t WS_MIX = WS_XB + 32 * MiB;
constexpr size_t WS_Q = WS_MIX;
constexpr size_t WS_K = WS_Q + 24 * MiB;
constexpr size_t WS_G = WS_K + 24 * MiB;
constexpr size_t WS_V = WS_G + 48 * MiB;
constexpr size_t WS_SG = WS_V + 32 * MiB;
constexpr size_t WS_M = WS_SG + 32 * MiB;
constexpr size_t WS_Y = WS_M + 64 * MiB;
constexpr size_t WS_MG = WS_Y + 32 * MiB;
constexpr size_t WS_LS = WS_MG + 32 * MiB;
constexpr size_t WS_SP = WS_LS + 128 * MiB;
constexpr size_t WS_MIX_END = WS_SP + 64 * MiB;
constexpr size_t WS_H = WS_MIX;
constexpr size_t WS_ACT = WS_MIX;
constexpr size_t WS_X8 = WS_ACT + 128 * MiB;
constexpr size_t WS_YP = WS_X8 + 16 * MiB;
static_assert(WS_YP + 144 * MiB <= WS_MIX_END, "MoE overlay fits the mixer region");
constexpr size_t WS_END = WS_MIX_END;
constexpr int CW_BAR = 4096;
constexpr int CW_CNT = 16384;

constexpr int RING_OFF = 0, RING_BYTES = 131072;
constexpr int LDSCTL_OFF = RING_BYTES, MISC_OFF = LDSCTL_OFF + 320;
constexpr int PART_OFF = RING_BYTES + 1024;
constexpr int LDS_BYTES = 147456;
constexpr int NWAVES = 8;

#define XB_TMO      128
#define XB_XCNT(j)  (256  + 64 * (j))
#define XB_XSUB(j)  (1280 + 64 * (j))
#define XB_XGEN(j)  (2304 + 64 * (j))
#define XB_TOP      3328
#define XB_TOPGEN   3392
#define XCD_BAR_WORDS 3456
#define XB_SPIN_CAP (1u << 18)

__device__ __forceinline__ unsigned xb_ld(unsigned* p)              { return __hip_atomic_load(p, __ATOMIC_RELAXED, __HIP_MEMORY_SCOPE_AGENT); }
__device__ __forceinline__ unsigned xb_add(unsigned* p, unsigned v) { return __hip_atomic_fetch_add(p, v, __ATOMIC_RELAXED, __HIP_MEMORY_SCOPE_AGENT); }
__device__ __forceinline__ unsigned xb_xcc_id() { return (unsigned)__builtin_amdgcn_s_getreg((3 << 11) | 20) & 0xFu; }
#define XB_SPIN(cond, bar) do { unsigned _sp = 0; while (cond) { __builtin_amdgcn_s_sleep(1); \
    if ((++_sp & 255u) == 0u) { if (xb_ld(&(bar)[XB_TMO])) break; if (_sp > XB_SPIN_CAP) { atomicAdd(&(bar)[XB_TMO], 1u); break; } } } } while (0)

struct XcdBarrier {
    unsigned* bar; unsigned x;
    volatile LAS unsigned* st;
};
__device__ __forceinline__ XcdBarrier xcd_barrier_post(unsigned* bar, volatile LAS unsigned* st) {
    XcdBarrier b; b.bar = bar; b.x = xb_xcc_id(); b.st = st;
    if (threadIdx.x == 0) (void)xb_add(&bar[XB_XCNT(b.x)], 1u);
    return b;
}
__device__ __forceinline__ void xcd_barrier_complete(unsigned* bar, unsigned x, unsigned& nloc, unsigned& nx) {
    const unsigned G = gridDim.x * gridDim.y * gridDim.z;
    unsigned sum, cnt, mine, sp = 0u;
    for (;;) {
        sum = 0u; cnt = 0u; mine = 0u;
#pragma unroll
        for (unsigned j = 0; j < 16; ++j) { const unsigned c = xb_ld(&bar[XB_XCNT(j)]); sum += c; cnt += (c > 0u) ? 1u : 0u; mine = (j == x) ? c : mine; }
        if (sum == G) break;
        __builtin_amdgcn_s_sleep(1);
        if ((++sp & 255u) == 0u) { if (xb_ld(&bar[XB_TMO])) break; if (sp > XB_SPIN_CAP) { atomicAdd(&bar[XB_TMO], 1u); break; } }
    }
    nloc = mine > 0u ? mine : 1u; nx = cnt > 0u ? cnt : 1u;
}
__device__ __forceinline__ void xcd_barrier(const XcdBarrier& b) {
    asm volatile("s_waitcnt vmcnt(0)" ::: "memory");
    __syncthreads();
    if (threadIdx.x == 0) {
        unsigned* bar = b.bar; asm volatile("" : "+s"(bar));
        __builtin_amdgcn_s_waitcnt(0);
        unsigned nloc = b.st[0], nx = b.st[1];
        if (nloc == 0u) { xcd_barrier_complete(bar, b.x, nloc, nx); b.st[0] = nloc; b.st[1] = nx; }
        const unsigned old = xb_add(&bar[XB_XSUB(b.x)], 1u);
        const unsigned gen = old / nloc;
        if (old + 1u == (gen + 1u) * nloc) {
            __builtin_amdgcn_fence(__ATOMIC_RELEASE, "agent");
            asm volatile("s_waitcnt vmcnt(0)" ::: "memory");
            const unsigned og = xb_add(&bar[XB_TOP], 1u);
            const unsigned tg = og / nx;
            if (og + 1u == (tg + 1u) * nx) xb_add(&bar[XB_TOPGEN], 1u);
            else XB_SPIN(xb_ld(&bar[XB_TOPGEN]) == tg, bar);
            __builtin_amdgcn_fence(__ATOMIC_ACQUIRE, "agent");
            xb_add(&bar[XB_XGEN(b.x)], 1u);
            asm volatile("s_waitcnt vmcnt(0)" ::: "memory");
        } else {
            XB_SPIN(xb_ld(&bar[XB_XGEN(b.x)]) == gen, bar);
            __builtin_amdgcn_fence(__ATOMIC_ACQUIRE, "agent");
            asm volatile("s_waitcnt vmcnt(0)" ::: "memory");
        }
    }
    __syncthreads();
}

struct ConvRegs { f32x4 w[8]; };
__device__ __forceinline__ void conv_load(ConvRegs& r, const float* W, int ldw, int c0, const float* kscale, int kb, int lane) {
    const int n4 = lane & 7, kg = lane >> 3; const float* src = W + (size_t)(64 * kb + 8 * kg) * ldw + c0 + 4 * n4;
#pragma unroll
    for (int i = 0; i < 8; ++i) r.w[i] = __builtin_nontemporal_load((const f32x4*)(src + (size_t)i * ldw));
    if (kscale) { const f32x4 s0 = *(const f32x4*)(kscale + 64 * kb + 8 * kg), s1 = *(const f32x4*)(kscale + 64 * kb + 8 * kg + 4);
#pragma unroll
        for (int i = 0; i < 4; ++i) { r.w[i] *= s0[i]; r.w[4 + i] *= s1[i]; } }
}
__device__ __forceinline__ void conv_store(const ConvRegs& r, int K, bf16* WT, int drow0, int kb, int lane) {
    const int n4 = lane & 7, kg = lane >> 3; bf16* dst = WT + (size_t)(drow0 + 4 * n4) * K + 64 * kb + 8 * kg;
#pragma unroll
    for (int j = 0; j < 4; ++j) { v4u o; o.x = cvt_pk_bf16(r.w[0][j], r.w[1][j]); o.y = cvt_pk_bf16(r.w[2][j], r.w[3][j]); o.z = cvt_pk_bf16(r.w[4][j], r.w[5][j]); o.w = cvt_pk_bf16(r.w[6][j], r.w[7][j]);
        *(v4u*)(dst + (size_t)j * K) = o; }
}
struct ConvJob { const float* W; const float* kscale; bf16* WT; int ldw, K, c0, drow0, kb; };
__device__ __forceinline__ unsigned pk4f8(float a, float b, float c, float d) { int w = 0; w = __builtin_amdgcn_cvt_pk_fp8_f32(a, b, w, false); w = __builtin_amdgcn_cvt_pk_fp8_f32(c, d, w, true); return (unsigned)w; }
__device__ __forceinline__ int gu_row(int c0, int isup) { return 256 * (c0 >> 7) + 128 * isup + (c0 & 127); }
struct Conv8Regs { f32x4 w[16]; };
__device__ __forceinline__ void conv8_load(Conv8Regs& r, const float* W, int ldw, int c0, int kb, int lane) {
    const int n4 = lane & 7, kg = lane >> 3; const float* src = W + (size_t)(128 * kb + 16 * kg) * ldw + c0 + 4 * n4;
#pragma unroll
    for (int i = 0; i < 16; ++i) r.w[i] = __builtin_nontemporal_load((const f32x4*)(src + (size_t)i * ldw));
}
__device__ __forceinline__ void conv8_store(const Conv8Regs& r, int K, const float* kscale, unsigned char* WT, int drow0, int kb, int lane) {
    const int n4 = lane & 7, kg = lane >> 3;
    float sc[16];
#pragma unroll
    for (int q = 0; q < 4; ++q) { f32x4 s4 = (f32x4){64.f, 64.f, 64.f, 64.f}; if (kscale) s4 = *(const f32x4*)(kscale + 128 * kb + 16 * kg + 4 * q) * 64.f; sc[4 * q] = s4[0]; sc[4 * q + 1] = s4[1]; sc[4 * q + 2] = s4[2]; sc[4 * q + 3] = s4[3]; }
    unsigned char* dst = WT + (size_t)(drow0 + 4 * n4) * K + 128 * kb + 16 * kg;
#pragma unroll
    for (int j = 0; j < 4; ++j) { v4u o;
        o.x = pk4f8(r.w[0][j] * sc[0], r.w[1][j] * sc[1], r.w[2][j] * sc[2], r.w[3][j] * sc[3]); o.y = pk4f8(r.w[4][j] * sc[4], r.w[5][j] * sc[5], r.w[6][j] * sc[6], r.w[7][j] * sc[7]);
        o.z = pk4f8(r.w[8][j] * sc[8], r.w[9][j] * sc[9], r.w[10][j] * sc[10], r.w[11][j] * sc[11]); o.w = pk4f8(r.w[12][j] * sc[12], r.w[13][j] * sc[13], r.w[14][j] * sc[14], r.w[15][j] * sc[15]);
        *(v4u*)(dst + (size_t)j * K) = o; }
}
struct Conv8Job { const float* W; const float* kscale; unsigned char* WT; int ldw, K, c0, drow0, kb; };
constexpr int I8_MG = 16 * 224, I8_MU = I8_MG, I8_MD = 56 * 64, I8_EXP = I8_MG + I8_MU + I8_MD, I8_ALL = NE * I8_EXP;
constexpr int I8_WIN = 2 * 16 * 128, I8_TOT = I8_ALL + I8_WIN;
struct Conv8Src { const float *wg, *wu, *wd, *fw, *win, *mw; };
__device__ __forceinline__ void conv8_decode(int it, const Conv8Src& c, unsigned char* ws, Conv8Job& j) {
    const float* wg = c.wg; const float* wu = c.wu; const float* wd = c.wd; const float* fw = c.fw;
    if (it >= I8_ALL) { const int r = it - I8_ALL, l = r >> 11, rr = r & 2047; j.kb = rr >> 7; const int nb = rr & 127;
        j.W = c.win + (size_t)l * D * DIN_SRC; j.ldw = DIN_SRC; j.K = D; j.c0 = 7184 + 32 * nb; j.kscale = c.mw + l * D; j.WT = ws + WS_WIN8 + (size_t)l * 4096 * D; j.drow0 = 32 * nb; return; }
    const int e = it / I8_EXP; int r = it - e * I8_EXP; unsigned char* wgu = ws + WS_WGUE + (size_t)e * 2 * DFFE * D;
    if (r < I8_MG) { j.kb = r / 224; const int nb = r % 224; j.W = wg + (size_t)e * D * DFFE; j.ldw = DFFE; j.K = D; j.c0 = 32 * nb; j.kscale = fw; j.WT = wgu; j.drow0 = gu_row(32 * nb, 0); return; } r -= I8_MG;
    if (r < I8_MU) { j.kb = r / 224; const int nb = r % 224; j.W = wu + (size_t)e * D * DFFE; j.ldw = DFFE; j.K = D; j.c0 = 32 * nb; j.kscale = fw; j.WT = wgu; j.drow0 = gu_row(32 * nb, 1); return; } r -= I8_MU;
    { j.kb = r / 64; const int nb = r % 64; j.W = wd + (size_t)e * DFFE * D; j.ldw = D; j.K = DFFE; j.c0 = 32 * nb; j.kscale = nullptr; j.WT = ws + WS_WDE + (size_t)e * D * DFFE; j.drow0 = 32 * nb; return; }
}
__device__ __forceinline__ void conv8_range(int lo, int hi, int w, int nw, const Conv8Src& c, unsigned char* ws, int lane) {
    Conv8Job j0, j1; Conv8Regs r0, r1; int i0 = lo + w, i1 = lo + w + nw;
    if (i0 < hi) { conv8_decode(i0, c, ws, j0); conv8_load(r0, j0.W, j0.ldw, j0.c0, j0.kb, lane); }
    if (i1 < hi) { conv8_decode(i1, c, ws, j1); conv8_load(r1, j1.W, j1.ldw, j1.c0, j1.kb, lane); }
    while (i0 < hi) {
        conv8_store(r0, j0.K, j0.kscale, j0.WT, j0.drow0, j0.kb, lane);
        i0 += 2 * nw; if (i0 < hi) { conv8_decode(i0, c, ws, j0); conv8_load(r0, j0.W, j0.ldw, j0.c0, j0.kb, lane); }
        if (i1 < hi) { conv8_store(r1, j1.K, j1.kscale, j1.WT, j1.drow0, j1.kb, lane);
            i1 += 2 * nw; if (i1 < hi) { conv8_decode(i1, c, ws, j1); conv8_load(r1, j1.W, j1.ldw, j1.c0, j1.kb, lane); } }
    }
}
struct P0Args {
    const float *x, *mix_norm_w, *w_in, *lbl, *gk_up_w, *w_proj_a, *w_proj_b, *w_out, *ffn_norm_w, *dense_w_gate, *dense_w_up, *dense_w_down, *moe_w_gate, *moe_w_up, *moe_w_down;
    unsigned char* ws;
};
__device__ __forceinline__ void p0_prologue(const P0Args& a, LAS unsigned char* lds, int vcu, int G, int wave, int lane) {
    const int gw = vcu * NWAVES + wave, NGW = G * NWAVES;
    unsigned char* ws = a.ws;
    constexpr int I_INA = 32 * 224, I_PA = 16 * 64, I_PB = 16 * 64, I_WO = 32 * 64;
    constexpr int I_LAYER = I_INA + I_PA + I_PB + I_WO;
    constexpr int I_DG = 32 * 176, I_DU = I_DG, I_DD = 88 * 64;
    constexpr int NITEMS = 2 * I_LAYER + I_DG + I_DU + I_DD;
    auto decode = [&](int it, ConvJob& j) {
        int r = it; j.kscale = nullptr;
        if (r < 2 * I_LAYER) {
            const int l = r / I_LAYER; r -= l * I_LAYER;
            const float* win = a.w_in + (size_t)l * D * DIN_SRC; bf16* wint = (bf16*)(ws + WS_WIN) + (size_t)l * NIN * D; const float* mw = a.mix_norm_w + l * D;
            if (r < I_INA) { j.kb = r / 224; const int nb = r % 224; j.W = win; j.ldw = DIN_SRC; j.K = D; j.c0 = 32 * nb; j.kscale = mw; j.WT = wint; j.drow0 = 32 * nb; return; } r -= I_INA;
            if (r < I_PA) { j.kb = r / 64; const int nb = r % 64; j.W = a.w_proj_a + (size_t)l * 1024 * D; j.ldw = D; j.K = 1024; j.c0 = 32 * nb; j.WT = (bf16*)(ws + WS_WPA) + (size_t)l * D * 1024; j.drow0 = 32 * nb; return; } r -= I_PA;
            if (r < I_PB) { j.kb = r / 64; const int nb = r % 64; j.W = a.w_proj_b + (size_t)l * 1024 * D; j.ldw = D; j.K = 1024; j.c0 = 32 * nb; j.WT = (bf16*)(ws + WS_WPB) + (size_t)l * D * 1024; j.drow0 = 32 * nb; return; } r -= I_PB;
            { j.kb = r / 64; const int nb = r % 64; j.W = a.w_out + (size_t)l * D * D; j.ldw = D; j.K = D; j.c0 = 32 * nb; j.WT = (bf16*)(ws + WS_WOUT) + (size_t)l * D * D; j.drow0 = 32 * nb; return; }
        }
        r -= 2 * I_LAYER;
        if (r < I_DG) { j.kb = r / 176; const int nb = r % 176; j.W = a.dense_w_gate; j.ldw = DFF; j.K = D; j.c0 = 32 * nb; j.kscale = a.ffn_norm_w; j.WT = (bf16*)(ws + WS_WGU0); j.drow0 = gu_row(32 * nb, 0); return; } r -= I_DG;
        if (r < I_DU) { j.kb = r / 176; const int nb = r % 176; j.W = a.dense_w_up; j.ldw = DFF; j.K = D; j.c0 = 32 * nb; j.kscale = a.ffn_norm_w; j.WT = (bf16*)(ws + WS_WGU0); j.drow0 = gu_row(32 * nb, 1); return; } r -= I_DU;
        { j.kb = r / 64; const int nb = r % 64; j.W = a.dense_w_down; j.ldw = D; j.K = DFF; j.c0 = 32 * nb; j.WT = (bf16*)(ws + WS_WD0); j.drow0 = 32 * nb; return; }
    };
    { ConvJob j[4]; ConvRegs r[4]; int ii[4];
#pragma unroll
      for (int q = 0; q < 4; ++q) { ii[q] = gw + q * NGW; if (ii[q] < NITEMS) { decode(ii[q], j[q]); conv_load(r[q], j[q].W, j[q].ldw, j[q].c0, j[q].kscale, j[q].kb, lane); } }
      while (ii[0] < NITEMS) {
#pragma unroll
          for (int q = 0; q < 4; ++q) { if (ii[q] < NITEMS) { conv_store(r[q], j[q].K, j[q].WT, j[q].drow0, j[q].kb, lane);
              ii[q] += 4 * NGW; if (ii[q] < NITEMS) { decode(ii[q], j[q]); conv_load(r[q], j[q].W, j[q].ldw, j[q].c0, j[q].kscale, j[q].kb, lane); } } }
      } }
    const int gt = (vcu * NWAVES + wave) * 64 + lane, NGT = NGW * 64;
    for (int idx = gt; idx < 2 * 512 * 256; idx += NGT) {
        const int l = idx / (512 * 256), rem = idx % (512 * 256), kq = rem / 512, j = rem % 512;
        const float* win = a.w_in + (size_t)l * D * DIN_SRC; const float* up = a.gk_up_w + (size_t)l * 16 * 512; const float* mw = a.mix_norm_w + l * D;
        float uj[16];
#pragma unroll
        for (int rr = 0; rr < 16; ++rr) uj[rr] = up[rr * 512 + j];
        float o[8];
#pragma unroll
        for (int kk = 0; kk < 8; ++kk) { const int k = 8 * kq + kk; const f32x4* wr = (const f32x4*)(win + (size_t)k * DIN_SRC + 7168); float s = 0.f;
#pragma unroll
            for (int q = 0; q < 4; ++q) { const f32x4 w = wr[q]; s += w[0] * uj[4 * q] + w[1] * uj[4 * q + 1] + w[2] * uj[4 * q + 2] + w[3] * uj[4 * q + 3]; }
            o[kk] = s * mw[k]; }
        v4u w; w.x = cvt_pk_bf16(o[0], o[1]); w.y = cvt_pk_bf16(o[2], o[3]); w.z = cvt_pk_bf16(o[4], o[5]); w.w = cvt_pk_bf16(o[6], o[7]);
        *(v4u*)((bf16*)(ws + WS_WIN) + (size_t)l * NIN * D + (size_t)(7168 + j) * D + 8 * kq) = w;
    }
    for (int idx = gt; idx < 2048; idx += NGT) { const int l = idx >> 10, c = idx & 1023; float v = 0.f;
        if (l == 1) { const float l0 = a.lbl[c], l1 = a.lbl[1024 + c]; v = 1.f / (1.f + __expf(l0 - l1)); }
        ((float*)(ws + WS_LBV))[idx] = v; }
    float* rsp0 = (float*)(ws + WS_RSP);
    for (int m = gw; m < T; m += NGW) {
        const f32x4* xr = (const f32x4*)(a.x + (size_t)m * D) + lane; f32x4 v[8]; float s = 0.f;
#pragma unroll
        for (int j = 0; j < 8; ++j) { v[j] = xr[64 * j]; s += (v[j][0] * v[j][0] + v[j][1] * v[j][1]) + (v[j][2] * v[j][2] + v[j][3] * v[j][3]); }
        s = wave_sum(s);
        v2u* o8 = (v2u*)((bf16*)(ws + WS_XB) + (size_t)m * D) + lane;
#pragma unroll
        for (int j = 0; j < 8; ++j) { v2u w; w.x = cvt_pk_bf16(v[j][0], v[j][1]); w.y = cvt_pk_bf16(v[j][2], v[j][3]); o8[64 * j] = w; }
        { unsigned* o4 = (unsigned*)(ws + WS_XB8 + (size_t)m * D) + lane;
#pragma unroll
          for (int j = 0; j < 8; ++j) o4[64 * j] = pack4_fp8(v[j][0] * X8_SCALE, v[j][1] * X8_SCALE, v[j][2] * X8_SCALE, v[j][3] * X8_SCALE); }
        if (lane == 0) { *(f32x4*)(rsp0 + (size_t)m * 8) = (f32x4){s, 0.f, 0.f, 0.f}; *(f32x4*)(rsp0 + (size_t)m * 8 + 4) = (f32x4){0.f, 0.f, 0.f, 0.f}; }
    }
}

typedef short v4i16_t __attribute__((ext_vector_type(4)));
__device__ __forceinline__ s16x4 tr_read(const LAS unsigned char* p) { return __builtin_bit_cast(s16x4, __builtin_amdgcn_ds_read_tr16_b64_v4i16((LAS v4i16_t*)p)); }
__device__ __forceinline__ bf16x8 tr_frag(const LAS unsigned char* img, int stride, int f0, int kk, int lane) {
    const int l16 = lane & 15, q = lane >> 4;
    const LAS unsigned char* p = img + (32 * kk + 8 * q + (l16 >> 2)) * stride + (f0 + 4 * (l16 & 3)) * 2;
    const s16x4 lo = tr_read(p), hi = tr_read(p + 4 * stride);
    bf16x8 r; r[0] = lo[0]; r[1] = lo[1]; r[2] = lo[2]; r[3] = lo[3]; r[4] = hi[0]; r[5] = hi[1]; r[6] = hi[2]; r[7] = hi[3]; return r;
}
__device__ __forceinline__ int head_ebase(int hh) { return hh < 8 ? hh * 16384 : 131072 + (hh - 8) * 32768; }
__device__ __forceinline__ int head_vcol(int hh) { return hh < 8 ? hh * 128 : 1024 + (hh - 8) * 256; }

struct LaPtrs { bf16 *Q, *Kb, *V, *SG, *Y, *SP, *LS; float *Gf, *DEC, *ER; const float *nwa, *nwb; };

struct ARegs { f32x4 g[4]; v2u q[4], k[4]; v4u v[4]; };
__device__ __forceinline__ void la_a_load(ARegs& R, const LaPtrs& P, int hh, int c, int tid) {
    const int dv = hh < 8 ? 128 : 256, qcol = hh * 128, vcol = head_vcol(hh), t0 = c * CH, dq = tid & 31, tg = tid >> 5, d0 = 4 * dq;
    const float* gp = P.Gf + (size_t)(t0 + 4 * tg) * QK_LD + qcol + d0;
#pragma unroll
    for (int s = 0; s < 4; ++s) { R.g[s] = *(const f32x4*)(gp + (size_t)s * QK_LD); const size_t idx = (size_t)(t0 + 4 * tg + s) * QK_LD + qcol + d0; R.q[s] = *(const v2u*)(P.Q + idx); R.k[s] = *(const v2u*)(P.Kb + idx); }
    const int cpr = dv / 8;
#pragma unroll
    for (int i = 0; i < 4; ++i) { if (i < dv / 64) { const int ch = tid + 512 * i, t = ch / cpr, cc = ch % cpr; R.v[i] = *(const v4u*)(P.V + (size_t)(t0 + t) * V_LD + vcol + cc * 8); } }
}
__device__ __forceinline__ void la_a_unit(const LaPtrs& P, LAS unsigned char* lds, int hh, int c, int tid, int wave, int lane, ARegs& R, bool has_next, int nhh, int nc) {
    const int dv = hh < 8 ? 128 : 256, qcol = hh * 128, t0 = c * CH;
    LAS float* tot = (LAS float*)lds;
    LAS float* elv = (LAS float*)(lds + 8192);
    LAS unsigned char* kimg = lds + 8192 + 512;
    LAS unsigned char* vimg = kimg + 64 * 288;
    const int vstride = (dv + 16) * 2;
    const int dq = tid & 31, tg = tid >> 5, d0 = 4 * dq;
    f32x4 cum[4];
    { f32x4 run = (f32x4){0.f, 0.f, 0.f, 0.f};
#pragma unroll
      for (int s = 0; s < 4; ++s) { run += R.g[s]; cum[s] = run; }
      *(LAS f32x4*)(tot + tg * 128 + d0) = run; }
    v2u qraw[4], kraw[4];
#pragma unroll
    for (int s = 0; s < 4; ++s) { qraw[s] = R.q[s]; kraw[s] = R.k[s]; }
    { const int cpr = dv / 8;
#pragma unroll
      for (int i = 0; i < 4; ++i) { if (i < dv / 64) { const int ch = tid + 512 * i, t = ch / cpr, cc = ch % cpr; *(LAS v4u*)(vimg + t * vstride + cc * 16) = R.v[i]; } } }
    if (has_next) la_a_load(R, P, nhh, nc, tid);
    __syncthreads();
    f32x4 off = (f32x4){0.f, 0.f, 0.f, 0.f}, cref = off, clast = off;
#pragma unroll
    for (int g = 0; g < 16; ++g) { const f32x4 tv = *(const LAS f32x4*)(tot + g * 128 + d0); if (g < tg) off += tv; if (g < 8) cref += tv; clast += tv; }
    if (tg == 0) { f32x4 e1, e2, e3;
#pragma unroll
        for (int j = 0; j < 4; ++j) { e1[j] = fast_exp(clast[j] - cref[j]); e2[j] = fast_exp(clast[j]); e3[j] = fast_exp(cref[j]); }
        *(LAS f32x4*)(elv + d0) = e1; *(f32x4*)(P.DEC + (size_t)(c * NHEADS + hh) * 128 + d0) = e2; *(f32x4*)(P.ER + (size_t)(c * NHEADS + hh) * 128 + d0) = e3; }
#pragma unroll
    for (int s = 0; s < 4; ++s) { const int t = 4 * tg + s; f32x4 eq, ek;
#pragma unroll
        for (int j = 0; j < 4; ++j) { const float x = clampf(cum[s][j] + off[j] - cref[j], -85.f, 85.f); eq[j] = fast_exp(x); ek[j] = fast_exp(-x); }
        v2u qo, ko; qo.x = cvt_pk_bf16(bflo(qraw[s].x) * eq[0], bfhi(qraw[s].x) * eq[1]); qo.y = cvt_pk_bf16(bflo(qraw[s].y) * eq[2], bfhi(qraw[s].y) * eq[3]);
        ko.x = cvt_pk_bf16(bflo(kraw[s].x) * ek[0], bfhi(kraw[s].x) * ek[1]); ko.y = cvt_pk_bf16(bflo(kraw[s].y) * ek[2], bfhi(kraw[s].y) * ek[3]);
        const size_t idx = (size_t)(t0 + t) * QK_LD + qcol + d0;
        *(v2u*)(P.Q + idx) = qo; *(v2u*)(P.Kb + idx) = ko; *(LAS v2u*)(kimg + t * 288 + d0 * 2) = ko; }
    __syncthreads();
    const int ntl = dv / 128;
    const int l16 = lane & 15, q4 = lane >> 4;
    bf16* LSc = P.LS + (size_t)c * STATE_E + head_ebase(hh);
    for (int ti = 0; ti < ntl; ++ti) {
        const int n0 = 16 * (wave * ntl + ti);
        const bf16x8 b0 = tr_frag(vimg, vstride, n0, 0, lane), b1 = tr_frag(vimg, vstride, n0, 1, lane);
#pragma unroll
        for (int dt = 0; dt < 8; ++dt) {
            const bf16x8 a0 = tr_frag(kimg, 288, 16 * dt, 0, lane), a1 = tr_frag(kimg, 288, 16 * dt, 1, lane);
            f32x4 acc = (f32x4){0.f, 0.f, 0.f, 0.f};
            acc = __builtin_amdgcn_mfma_f32_16x16x32_bf16(a0, b0, acc, 0, 0, 0);
            acc = __builtin_amdgcn_mfma_f32_16x16x32_bf16(a1, b1, acc, 0, 0, 0);
            const f32x4 el = *(const LAS f32x4*)(elv + 16 * dt + 4 * q4);
            { const f32x4 lv = acc * el; v2u w; w.x = cvt_pk_bf16(lv[0], lv[1]); w.y = cvt_pk_bf16(lv[2], lv[3]); *(v2u*)(LSc + (size_t)(n0 + l16) * 128 + 16 * dt + 4 * q4) = w; }
        }
    }
    __syncthreads();
}

__device__ __forceinline__ void la_b_scan(const LaPtrs& P, LAS unsigned char* lds, int bx, int G, int tid) {
    LAS float* decs = (LAS float*)lds; LAS float* ers = (LAS float*)(lds + 65536);
    for (int p0 = bx * 256; p0 < STATE_E / 4; p0 += G * 256) {
        const int e0 = 4 * p0; const int hh = e0 < 131072 ? (e0 >> 14) : 8 + ((e0 - 131072) >> 15);
        for (int i = tid; i < 4096; i += 512) { const int c = i >> 5, q = i & 31;
            *(LAS f32x4*)(decs + c * 128 + 4 * q) = *(const f32x4*)(P.DEC + (size_t)(c * NHEADS + hh) * 128 + 4 * q);
            *(LAS f32x4*)(ers + c * 128 + 4 * q) = *(const f32x4*)(P.ER + (size_t)(c * NHEADS + hh) * 128 + 4 * q); }
        __syncthreads();
        {
            const int e = e0 + 2 * tid, d = e & 127;
            f32x2_t s = (f32x2_t){0.f, 0.f};
            const bf16* lsp = P.LS + e; bf16* spp = P.SP + e;
            unsigned cur[32], nxt[32];
#pragma unroll
            for (int j = 0; j < 32; ++j) cur[j] = __builtin_nontemporal_load((const unsigned*)(lsp + (size_t)j * STATE_E));
            for (int c0 = 0; c0 < NCH; c0 += 32) {
                if (c0 + 32 < NCH) {
#pragma unroll
                    for (int j = 0; j < 32; ++j) nxt[j] = __builtin_nontemporal_load((const unsigned*)(lsp + (size_t)(c0 + 32 + j) * STATE_E)); }
#pragma unroll
                for (int j = 0; j < 32; ++j) { const int c = c0 + j;
                    const f32x2_t er = *(const LAS f32x2_t*)(ers + c * 128 + d), dc = *(const LAS f32x2_t*)(decs + c * 128 + d);
                    const f32x2_t l = (f32x2_t){bflo(cur[j]), bfhi(cur[j])};
                    const f32x2_t sp = er * s;
                    *(unsigned*)(spp + (size_t)c * STATE_E) = cvt_pk_bf16(sp[0], sp[1]);
                    s = dc * s + l; }
#pragma unroll
                for (int j = 0; j < 32; ++j) cur[j] = nxt[j];
            }
        }
        __syncthreads();
    }
}

struct CRegs { v4u q[2], k[2], v[4]; };
__device__ __forceinline__ void la_c_load(CRegs& R, const LaPtrs& P, int hh, int c, int tid) {
    const int dv = hh < 8 ? 128 : 256, qcol = hh * 128, vcol = head_vcol(hh), t0 = c * CH;
    { const int t = tid >> 3, cc = tid & 7; const bf16* qp = P.Q + (size_t)(t0 + t) * QK_LD + qcol + cc * 8; const bf16* kp = P.Kb + (size_t)(t0 + t) * QK_LD + qcol + cc * 8;
      R.q[0] = *(const v4u*)qp; R.q[1] = *(const v4u*)(qp + 64); R.k[0] = *(const v4u*)kp; R.k[1] = *(const v4u*)(kp + 64); }
    const int cpr = dv / 8;
#pragma unroll
    for (int i = 0; i < 4; ++i) { if (i < dv / 64) { const int ch = tid + 512 * i, t = ch / cpr, cc = ch % cpr; R.v[i] = *(const v4u*)(P.V + (size_t)(t0 + t) * V_LD + vcol + cc * 8); } }
}
__device__ __forceinline__ void la_c_unit(const LaPtrs& P, LAS unsigned char* lds, int hh, int c, int tid, int wave, int lane, CRegs& R, bool has_next, int nhh, int nc) {
    const int dv = hh < 8 ? 128 : 256, qcol = hh * 128, vcol = head_vcol(hh), t0 = c * CH;
    LAS unsigned char* As = lds;
    LAS float* red = (LAS float*)(lds + 9216);
    LAS unsigned char* qimg = lds + 12288;
    LAS unsigned char* kimg = qimg + 64 * 272;
    LAS unsigned char* vimg = kimg + 64 * 272;
    const int vstride = (dv + 16) * 2;
    const int l16 = lane & 15, q4 = lane >> 4;
    const int ntl = dv / 128;
    { const int t = tid >> 3, cc = tid & 7;
      *(LAS v4u*)(qimg + t * 272 + cc * 16) = R.q[0]; *(LAS v4u*)(qimg + t * 272 + 128 + cc * 16) = R.q[1]; *(LAS v4u*)(kimg + t * 272 + cc * 16) = R.k[0]; *(LAS v4u*)(kimg + t * 272 + 128 + cc * 16) = R.k[1]; }
    { const int cpr = dv / 8;
#pragma unroll
      for (int i = 0; i < 4; ++i) { if (i < dv / 64) { const int ch = tid + 512 * i, t = ch / cpr, cc = ch % cpr; *(LAS v4u*)(vimg + t * vstride + cc * 16) = R.v[i]; } } }
    const bf16* SPc = P.SP + (size_t)c * STATE_E + head_ebase(hh);
    bf16x8 as[2][4];
    v2u gt[2][4]; f32x4 nwv[2];
    const float* nw = hh < 8 ? P.nwa : P.nwb;
#pragma unroll
    for (int ti = 0; ti < 2; ++ti) { if (ti < ntl) { const int n0 = 16 * (wave * ntl + ti);
#pragma unroll
        for (int kk = 0; kk < 4; ++kk) as[ti][kk] = *(const bf16x8*)(SPc + (size_t)(n0 + l16) * 128 + 32 * kk + 8 * q4);
        nwv[ti] = *(const f32x4*)(nw + n0 + 4 * q4);
#pragma unroll
        for (int it = 0; it < 4; ++it) gt[ti][it] = *(const v2u*)(P.SG + (size_t)(t0 + 16 * it + l16) * V_LD + vcol + n0 + 4 * q4); } }
    if (has_next) la_c_load(R, P, nhh, nc, tid);
    __syncthreads();
    { const int jt = wave >> 1;
#pragma unroll
      for (int ii = 0; ii < 2; ++ii) { const int it = 2 * (wave & 1) + ii; const int j0 = 16 * jt, i0 = 16 * it;
          f32x4 acc = (f32x4){0.f, 0.f, 0.f, 0.f};
          if (jt <= it) {
#pragma unroll
              for (int kk = 0; kk < 4; ++kk) { const bf16x8 kf = *(const LAS bf16x8*)(kimg + (j0 + l16) * 272 + (32 * kk + 8 * q4) * 2), qf = *(const LAS bf16x8*)(qimg + (i0 + l16) * 272 + (32 * kk + 8 * q4) * 2);
                  acc = __builtin_amdgcn_mfma_f32_16x16x32_bf16(kf, qf, acc, 0, 0, 0); } }
          const int i = i0 + l16; f32x4 mv;
#pragma unroll
          for (int jj = 0; jj < 4; ++jj) mv[jj] = (j0 + 4 * q4 + jj <= i) ? acc[jj] : 0.f;
          v2u w; w.x = cvt_pk_bf16(mv[0], mv[1]); w.y = cvt_pk_bf16(mv[2], mv[3]);
          *(LAS v2u*)(As + i * 144 + (j0 + 4 * q4) * 2) = w; } }
    __syncthreads();
    f32x4 o[2][4];
#pragma unroll
    for (int ti = 0; ti < 2; ++ti)
#pragma unroll
        for (int it = 0; it < 4; ++it) o[ti][it] = (f32x4){0.f, 0.f, 0.f, 0.f};
#pragma unroll
    for (int it = 0; it < 4; ++it) { const int i0 = 16 * it;
        const bf16x8 bf0 = *(const LAS bf16x8*)(As + (i0 + l16) * 144 + (8 * q4) * 2), bf1 = *(const LAS bf16x8*)(As + (i0 + l16) * 144 + (32 + 8 * q4) * 2);
        bf16x8 bq[4];
#pragma unroll
        for (int kk = 0; kk < 4; ++kk) bq[kk] = *(const LAS bf16x8*)(qimg + (i0 + l16) * 272 + (32 * kk + 8 * q4) * 2);
#pragma unroll
        for (int ti = 0; ti < 2; ++ti) { if (ti < ntl) { const int n0 = 16 * (wave * ntl + ti);
            const bf16x8 av0 = tr_frag(vimg, vstride, n0, 0, lane), av1 = tr_frag(vimg, vstride, n0, 1, lane);
            f32x4 acc = (f32x4){0.f, 0.f, 0.f, 0.f};
            acc = __builtin_amdgcn_mfma_f32_16x16x32_bf16(av0, bf0, acc, 0, 0, 0);
            acc = __builtin_amdgcn_mfma_f32_16x16x32_bf16(av1, bf1, acc, 0, 0, 0);
#pragma unroll
            for (int kk = 0; kk < 4; ++kk) acc = __builtin_amdgcn_mfma_f32_16x16x32_bf16(as[ti][kk], bq[kk], acc, 0, 0, 0);
            o[ti][it] = acc; } } }
#pragma unroll
    for (int it = 0; it < 4; ++it) { float s = 0.f;
#pragma unroll
        for (int ti = 0; ti < 2; ++ti) s += (o[ti][it][0] * o[ti][it][0] + o[ti][it][1] * o[ti][it][1]) + (o[ti][it][2] * o[ti][it][2] + o[ti][it][3] * o[ti][it][3]);
        s += __shfl_xor(s, 16); s += __shfl_xor(s, 32);
        if (q4 == 0) red[(16 * it + l16) * 8 + wave] = s; }
    __syncthreads();
    const float inv_dv = 1.0f / (float)dv;
#pragma unroll
    for (int it = 0; it < 4; ++it) { const int i = 16 * it + l16;
        const f32x4 ra = *(const LAS f32x4*)(red + i * 8), rb = *(const LAS f32x4*)(red + i * 8 + 4);
        const float r = __builtin_amdgcn_rsqf(((ra[0] + ra[1]) + (ra[2] + ra[3]) + (rb[0] + rb[1]) + (rb[2] + rb[3])) * inv_dv + EPS);
#pragma unroll
        for (int ti = 0; ti < 2; ++ti) { if (ti < ntl) { const int n = 16 * (wave * ntl + ti) + 4 * q4; const size_t idx = (size_t)(t0 + i) * V_LD + vcol + n;
            const f32x4 w = nwv[ti]; const v2u g = gt[ti][it];
            v2u y; y.x = cvt_pk_bf16(o[ti][it][0] * r * w[0] * bflo(g.x), o[ti][it][1] * r * w[1] * bfhi(g.x)); y.y = cvt_pk_bf16(o[ti][it][2] * r * w[2] * bflo(g.y), o[ti][it][3] * r * w[3] * bfhi(g.y));
            *(v2u*)(P.Y + idx) = y; } } }
    __syncthreads();
}

struct MoePtrs { const bf16* XB; const float* router_w; const float* router_b; const float* fnw; unsigned* counts; int* list; unsigned char* X8; int* tslot; float* tw; };
__device__ __forceinline__ void moe_router(const MoePtrs& P, LAS unsigned char* lds, int gw, int NGW, int wave, int lane) {
    LAS unsigned* cntl = (LAS unsigned*)lds; LAS unsigned* basel = cntl + 8;
    LAS float* rw = (LAS float*)(lds + 256);
    const int tid = wave * 64 + lane;
    for (int i = tid; i < D * NE / 4; i += 512) { const int k = i >> 1, half = i & 1, L = (k >> 2) & 63, slot = (k >> 8) * 4 + (k & 3); const float g = P.fnw[k];
        *(LAS f32x4*)(rw + ((half * 32 + slot) * 64 + L) * 4) = *(const f32x4*)(P.router_w + 4 * i) * g; }
    constexpr int RK = 4;
    for (int tb0 = 0; tb0 < T; tb0 += RK * NGW) {
        if (tid < 8) cntl[tid] = 0u;
        __syncthreads();
        int e0s[RK], e1s[RK]; float w0s[RK]; unsigned r0s[RK], r1s[RK];
        v2u xall[RK][8];
#pragma unroll
        for (int kq = 0; kq < RK; ++kq) { const int t = tb0 + kq * NGW + gw; const v2u* xr = (const v2u*)(P.XB + (size_t)(t < T ? t : 0) * D) + lane;
#pragma unroll
            for (int j = 0; j < 8; ++j) xall[kq][j] = xr[64 * j]; }
#pragma unroll
        for (int kq = 0; kq < RK; ++kq) { const int t = tb0 + kq * NGW + gw; e0s[kq] = -1; e1s[kq] = -1; w0s[kq] = 0.f; r0s[kq] = 0u; r1s[kq] = 0u;
            if (t < T) {
                float ss = 0.f; float lg[NE]; f32x4 xv[8];
#pragma unroll
                for (int e = 0; e < NE; ++e) lg[e] = 0.f;
#pragma unroll
                for (int j = 0; j < 8; ++j) xv[j] = (f32x4){bflo(xall[kq][j].x), bfhi(xall[kq][j].x), bflo(xall[kq][j].y), bfhi(xall[kq][j].y)};
#pragma unroll
                for (int j = 0; j < 8; ++j) { const f32x4 x = xv[j]; ss += (x[0] * x[0] + x[1] * x[1]) + (x[2] * x[2] + x[3] * x[3]);
#pragma unroll
                    for (int i = 0; i < 4; ++i) { const float xw = x[i]; const f32x4 r0 = *(const LAS f32x4*)(rw + ((4 * j + i) * 64 + lane) * 4), r1 = *(const LAS f32x4*)(rw + ((32 + 4 * j + i) * 64 + lane) * 4);
                        lg[0] += xw * r0[0]; lg[1] += xw * r0[1]; lg[2] += xw * r0[2]; lg[3] += xw * r0[3]; lg[4] += xw * r1[0]; lg[5] += xw * r1[1]; lg[6] += xw * r1[2]; lg[7] += xw * r1[3]; } }
                ss = wave_sum(ss); const float rs = __builtin_amdgcn_rsqf(ss * (1.0f / D) + EPS);
                { unsigned* x8 = (unsigned*)(P.X8 + (size_t)t * D) + lane;
#pragma unroll
                  for (int j = 0; j < 8; ++j) x8[64 * j] = pk4f8(xv[j][0] * rs, xv[j][1] * rs, xv[j][2] * rs, xv[j][3] * rs); }
#pragma unroll
                for (int e = 0; e < NE; ++e) lg[e] = wave_sum(lg[e]) * rs + P.router_b[e];
                int e0 = 0; float l0 = lg[0];
#pragma unroll
                for (int e = 1; e < NE; ++e) if (lg[e] > l0) { l0 = lg[e]; e0 = e; }
                int e1 = -1; float l1 = -3.0e38f;
#pragma unroll
                for (int e = 0; e < NE; ++e) if (e != e0 && lg[e] > l1) { l1 = lg[e]; e1 = e; }
                e0s[kq] = e0; e1s[kq] = e1; w0s[kq] = 1.0f / (1.0f + __expf(l1 - l0));
                if (lane == 0) { r0s[kq] = __hip_atomic_fetch_add(cntl + e0, 1u, __ATOMIC_RELAXED, __HIP_MEMORY_SCOPE_WORKGROUP); r1s[kq] = __hip_atomic_fetch_add(cntl + e1, 1u, __ATOMIC_RELAXED, __HIP_MEMORY_SCOPE_WORKGROUP); }
            } }
        __syncthreads();
        if (tid < 8) basel[tid] = __hip_atomic_fetch_add(P.counts + tid, cntl[tid], RLX_AGENT);
        __syncthreads();
        if (lane == 0) {
#pragma unroll
            for (int kq = 0; kq < RK; ++kq) { const int t = tb0 + kq * NGW + gw; if (t < T) { const int e0 = e0s[kq], e1 = e1s[kq];
                const unsigned p0 = basel[e0] + r0s[kq], p1 = basel[e1] + r1s[kq];
                if (p0 < (unsigned)MOE_CAP) P.list[e0 * MOE_CAP + p0] = t;
                if (p1 < (unsigned)MOE_CAP) P.list[e1 * MOE_CAP + p1] = t;
                P.tslot[2 * t] = e0 * MOE_CAP + (int)p0; P.tslot[2 * t + 1] = e1 * MOE_CAP + (int)p1; P.tw[2 * t] = w0s[kq]; P.tw[2 * t + 1] = 1.0f - w0s[kq]; } } }
        __syncthreads();
    }
}
__device__ __forceinline__ void final_phase(const bf16* XB, const bf16* YP, const int* tslot, const float* tw, const MoeTiles& mt, const float* fw, float* out, int gw, int NGW, int lane) {
    for (int t = gw; t < T; t += NGW) {
        const int s0 = tslot[2 * t], s1 = tslot[2 * t + 1]; const float w0 = tw[2 * t], w1 = tw[2 * t + 1];
        const int e0 = s0 / MOE_CAP, p0 = s0 % MOE_CAP, e1 = s1 / MOE_CAP, p1 = s1 % MOE_CAP;
        const size_t r0 = (size_t)mt.tb_of(e0) * 256 + p0, r1 = (size_t)mt.tb_of(e1) * 256 + p1;
        const v2u* xr = (const v2u*)(XB + (size_t)t * D) + lane; const v2u* y0 = (const v2u*)(YP + r0 * D) + lane; const v2u* y1 = (const v2u*)(YP + r1 * D) + lane; const size_t hb = (size_t)MOE_MAXT * 256 * D / 4;
        f32x4 v[8]; float ss = 0.f;
#pragma unroll
        for (int j = 0; j < 8; ++j) { const v2u xw = xr[64 * j]; const f32x4 x = (f32x4){bflo(xw.x), bfhi(xw.x), bflo(xw.y), bfhi(xw.y)}; const v2u a = y0[64 * j], b = y1[64 * j], a2 = y0[hb + 64 * j], b2 = y1[hb + 64 * j];
            v[j][0] = x[0] + w0 * (bflo(a.x) + bflo(a2.x)) + w1 * (bflo(b.x) + bflo(b2.x)); v[j][1] = x[1] + w0 * (bfhi(a.x) + bfhi(a2.x)) + w1 * (bfhi(b.x) + bfhi(b2.x));
            v[j][2] = x[2] + w0 * (bflo(a.y) + bflo(a2.y)) + w1 * (bflo(b.y) + bflo(b2.y)); v[j][3] = x[3] + w0 * (bfhi(a.y) + bfhi(a2.y)) + w1 * (bfhi(b.y) + bfhi(b2.y));
            ss += (v[j][0] * v[j][0] + v[j][1] * v[j][1]) + (v[j][2] * v[j][2] + v[j][3] * v[j][3]); }
        ss = wave_sum(ss); const float rs = __builtin_amdgcn_rsqf(ss * (1.0f / D) + EPS);
        f32x4* orow = (f32x4*)(out + (size_t)t * D) + lane; const f32x4* fwv = (const f32x4*)fw + lane;
#pragma unroll
        for (int j = 0; j < 8; ++j) orow[64 * j] = v[j] * rs * fwv[64 * j];
    }
}
#ifndef PHASE_MASK
#define PHASE_MASK 0x1fff
#endif
#define PH_ON(k) (((PHASE_MASK) >> (k)) & 1)
#ifndef CONV_CUTS
#define CONV_CUTS 1000, 1000, 1000, 1000
#endif
#ifndef MK_SPLIT
#define MK_SPLIT 0
#endif
constexpr int N_PHASES = 20;
struct Args { const float* in[21]; float* out; unsigned char* ws; int ph_lo, ph_hi, flags, pad; };
static_assert(sizeof(Args) == 21 * 8 + 8 + 8 + 16, "Args has no padding");

__device__ __forceinline__ unsigned char* ws_of(const Args& a) { size_t z = 0; asm volatile("" : "+s"(z)); return a.ws + z; }
__device__ __forceinline__ const float* in_of(const Args& a, int i) { asm volatile("" : "+s"(i)); return a.in[i]; }

__global__ void __launch_bounds__(NWAVES * 64, 2) trunk_fwd(Args args) {
    extern __shared__ __attribute__((aligned(16))) unsigned char lds_raw[];
    LAS unsigned char* lds = (LAS unsigned char*)lds_raw;
    volatile LAS unsigned* MISC = (volatile LAS unsigned*)(lds + MISC_OFF);
    const int G = gridDim.x; const int bx = blockIdx.x; const int vcu = (G % 8 == 0) ? (bx % 8) * (G / 8) + bx / 8 : bx;
    for (int u = threadIdx.x; u < (LDS_BYTES - LDSCTL_OFF) / 4; u += NWAVES * 64) ((LAS unsigned*)(lds + LDSCTL_OFF))[u] = 0u;
    __syncthreads();
    XcdBarrier bar; bar.bar = (unsigned*)(args.ws + WS_CTL) + CW_BAR; bar.x = 0; bar.st = nullptr;
    if (!MK_SPLIT) bar = xcd_barrier_post((unsigned*)(args.ws + WS_CTL) + CW_BAR, MISC + 8);
    const int lo = args.ph_lo, hi = args.ph_hi;
#define IN(k) (lo <= (k) && (k) < hi)
#define SEAM(k) do { if (!MK_SPLIT && IN((k) + 1)) xcd_barrier(bar); } while (0)
    const int NGW = G * NWAVES;
#define NSPARE(nunits) (MK_SPLIT ? 0 : (G - (((nunits) + (((nunits) + G - 1) / G) - 1) / (((nunits) + G - 1) / G))))
#define CONV_SLICE(k, nc) do { } while (0)
#define PH_TID() int tz_ = threadIdx.x; asm volatile("" : "+v"(tz_)); const int tid = tz_, lane = tz_ & 63, wave = __builtin_amdgcn_readfirstlane(tz_ >> 6), gw = vcu * NWAVES + wave; (void)tid; (void)lane; (void)gw

    if (PH_ON(0) && IN(0)) {
        unsigned char* ws = ws_of(args); PH_TID();
        P0Args a; a.x = in_of(args, 0); a.mix_norm_w = in_of(args, 1); a.w_in = in_of(args, 2); a.lbl = in_of(args, 3); a.gk_up_w = in_of(args, 4); a.w_proj_a = in_of(args, 8); a.w_proj_b = in_of(args, 9); a.w_out = in_of(args, 10);
        a.ffn_norm_w = in_of(args, 11); a.dense_w_gate = in_of(args, 12); a.dense_w_up = in_of(args, 13); a.dense_w_down = in_of(args, 14); a.moe_w_gate = in_of(args, 17); a.moe_w_up = in_of(args, 18); a.moe_w_down = in_of(args, 19); a.ws = ws;
        { Conv8Src c8; c8.wg = a.moe_w_gate; c8.wu = a.moe_w_up; c8.wd = a.moe_w_down; c8.fw = a.ffn_norm_w + D; c8.win = a.w_in; c8.mw = a.mix_norm_w;
          conv8_range(0, I8_TOT, vcu * NWAVES + wave, G * NWAVES, c8, ws, lane); }
        p0_prologue(a, lds, vcu, G, wave, lane);
        SEAM(0);
    }
    for (int layer = 0; layer < DEPTH; ++layer) {
        const int pb = 1 + 9 * layer;
#define LP_SETUP() LaPtrs LP; LP.Q = (bf16*)(ws + WS_Q); LP.Kb = (bf16*)(ws + WS_K); LP.V = (bf16*)(ws + WS_V); LP.SG = (bf16*)(ws + WS_SG); LP.Y = (bf16*)(ws + WS_Y); LP.SP = (bf16*)(ws + WS_SP); \
        LP.Gf = (float*)(ws + WS_G); LP.LS = (bf16*)(ws + WS_LS); LP.DEC = (float*)(ws + WS_DEC); LP.ER = (float*)(ws + WS_ER); LP.nwa = nullptr; LP.nwb = nullptr;
        if (PH_ON(1) && IN(pb + 0)) {
            unsigned char* ws = ws_of(args); PH_TID();
            { SchedDense8 S; S.A = (const char*)(ws + WS_XB8); S.Bt = (const char*)(ws + WS_WIN8 + (size_t)layer * 4096 * D); S.nM = T / 256; S.nN = 16; S.G = G; S.c = bx; S.skip_epi = args.flags & 1; S.shape(D, D);
              EpiIn8 E; E.rsq = (const float*)(ws + WS_RSP) + (size_t)(2 * layer) * T * 8; E.M = ws + WS_M;
              pg8::gemm_phase<EpiIn8, SchedDense8, true>(lds + RING_OFF, S, E); }
            __syncthreads();
            { const int nc = NSPARE((T / 256) * NIN_BF);
              SchedDense S; S.A = (const char*)(ws + WS_XB); S.Bt = (const char*)((bf16*)(ws + WS_WIN) + (size_t)layer * NIN * D); S.nM = bx < nc ? 0 : T / 256; S.nN = NIN_BF; S.G = G - nc; S.c = bx < nc ? 0 : bx - nc; S.skip_epi = args.flags & 1; S.shape(D, D);
              EpiIn E; E.rsq = (const float*)(ws + WS_RSP) + (size_t)(2 * layer) * T * 8; E.Q = (bf16*)(ws + WS_Q); E.Kb = (bf16*)(ws + WS_K); E.V = (bf16*)(ws + WS_V); E.SG = (bf16*)(ws + WS_SG); E.M = (bf16*)(ws + WS_M); E.Gf = (float*)(ws + WS_G);
              E.lbv = (const float*)(ws + WS_LBV) + layer * 1024; E.gkb = in_of(args, 5) + layer * 512;
              pg8::gemm_phase<EpiIn, SchedDense, true>(lds + RING_OFF, S, E); }
            SEAM(pb + 0);
        }
        if (PH_ON(2) && IN(pb + 1)) {
            unsigned char* ws = ws_of(args); PH_TID(); LP_SETUP();
            { ARegs R; la_a_load(R, LP, (bx % (NHEADS * NCH)) % NHEADS, (bx % (NHEADS * NCH)) / NHEADS, tid);
              for (int u = bx; u < NHEADS * NCH; u += G) { const int un = u + G; la_a_unit(LP, lds, u % NHEADS, u / NHEADS, tid, wave, lane, R, un < NHEADS * NCH, un % NHEADS, un / NHEADS); } }
            SEAM(pb + 1);
        }
        if (PH_ON(3) && IN(pb + 2)) {
            unsigned char* ws = ws_of(args); PH_TID(); LP_SETUP();
            la_b_scan(LP, lds, bx, G, tid);
            SEAM(pb + 2);
        }
        if (PH_ON(4) && IN(pb + 3)) {
            unsigned char* ws = ws_of(args); PH_TID(); LP_SETUP(); LP.nwa = in_of(args, 6) + layer * 128; LP.nwb = in_of(args, 7) + layer * 256;
            { CRegs R; la_c_load(R, LP, (bx % (NHEADS * NCH)) % NHEADS, (bx % (NHEADS * NCH)) / NHEADS, tid);
              for (int u = bx; u < NHEADS * NCH; u += G) { const int un = u + G; la_c_unit(LP, lds, u % NHEADS, u / NHEADS, tid, wave, lane, R, un < NHEADS * NCH, un % NHEADS, un / NHEADS); } }
            SEAM(pb + 3);
        }
        if (PH_ON(5) && IN(pb + 4)) {
            unsigned char* ws = ws_of(args); PH_TID();
            SchedProj S; S.Y = (const char*)(ws + WS_Y); S.Wa = (const char*)((bf16*)(ws + WS_WPA) + (size_t)layer * D * 1024); S.Wb = (const char*)((bf16*)(ws + WS_WPB) + (size_t)layer * D * 1024); S.G = G; S.c = bx; S.skip_epi = args.flags & 1; S.ldaB = D * 2; S.ldbB = 1024 * 2; S.KB = 1024 * 2;
            EpiProj E; E.M = ws + WS_M; E.MG = (bf16*)(ws + WS_MG);
            pg8::gemm_phase<EpiProj, SchedProj, false>(lds + RING_OFF, S, E);
            SEAM(pb + 4);
        }
        if (PH_ON(6) && IN(pb + 5)) {
            unsigned char* ws = ws_of(args); PH_TID();
            SchedDense S; S.A = (const char*)(ws + WS_MG); S.Bt = (const char*)((bf16*)(ws + WS_WOUT) + (size_t)layer * D * D); S.nM = T / 256; S.nN = D / 256; S.G = G; S.c = bx; S.skip_epi = args.flags & 1; S.shape(D, D);
            EpiRes E; E.xb = (bf16*)(ws + WS_XB); E.rsp_out = (float*)(ws + WS_RSP) + (size_t)(layer == 0 ? 1 : 2) * T * 8; E.part = (LAS float*)(lds + PART_OFF);
            E.x8 = nullptr;
            pg8::gemm_phase<EpiRes, SchedDense, true>(lds + RING_OFF, S, E);
            SEAM(pb + 5);
        }
        if (layer == 0) {
            if (PH_ON(7) && IN(pb + 6)) {
                unsigned char* ws = ws_of(args); PH_TID();
                const int nc = NSPARE((T / 256) * ((2 * DFF) / 256));
                if (bx < nc) { if (!(args.flags & 1)) CONV_SLICE(2, nc); }
                SchedDense S; S.A = (const char*)(ws + WS_XB); S.Bt = (const char*)(ws + WS_WGU0); S.nM = bx < nc ? 0 : T / 256; S.nN = (2 * DFF) / 256; S.G = G - nc; S.c = bx < nc ? 0 : bx - nc; S.skip_epi = args.flags & 1; S.shape(D, D);
                EpiGU E; E.rsq = (const float*)(ws + WS_RSP) + (size_t)1 * T * 8; E.H = (bf16*)(ws + WS_H); E.ldh = DFF;
                pg8::gemm_phase<EpiGU, SchedDense, true>(lds + RING_OFF, S, E);
                SEAM(pb + 6);
            }
            if (PH_ON(8) && IN(pb + 7)) {
                unsigned char* ws = ws_of(args); PH_TID();
                SchedDense S; S.A = (const char*)(ws + WS_H); S.Bt = (const char*)(ws + WS_WD0); S.nM = T / 256; S.nN = D / 256; S.G = G; S.c = bx; S.skip_epi = args.flags & 1; S.shape(DFF, DFF);
                EpiRes E; E.xb = (bf16*)(ws + WS_XB); E.rsp_out = (float*)(ws + WS_RSP) + (size_t)2 * T * 8; E.part = (LAS float*)(lds + PART_OFF); E.x8 = ws + WS_XB8;
                pg8::gemm_phase<EpiRes, SchedDense, true>(lds + RING_OFF, S, E);
                SEAM(pb + 8);
            }
        } else {
            if (PH_ON(9) && IN(pb + 6)) {
                unsigned char* ws = ws_of(args); PH_TID();
                MoePtrs MP; MP.XB = (const bf16*)(ws + WS_XB); MP.router_w = in_of(args, 15); MP.router_b = in_of(args, 16); MP.fnw = in_of(args, 11) + D; MP.counts = (unsigned*)(ws + WS_CTL) + CW_CNT;
                MP.list = (int*)(ws + WS_LIST); MP.X8 = ws + WS_X8; MP.tslot = (int*)(ws + WS_TSLOT); MP.tw = (float*)(ws + WS_TW);
                moe_router(MP, lds, gw, NGW, wave, lane);
                SEAM(pb + 6);
            }
            if (PH_ON(10) && IN(pb + 7)) {
                unsigned char* ws = ws_of(args); PH_TID();
                SchedMoeGU S; S.X8 = (const char*)(ws + WS_X8); S.W = (const char*)(ws + WS_WGUE); S.list = (const int*)(ws + WS_LIST); S.mt.load((const unsigned*)(ws + WS_CTL) + CW_CNT); S.G = G; S.c = bx; S.skip_epi = args.flags & 1; S.ldaB = D; S.ldbB = D; S.KB = D;
                EpiGUMoe E; E.ACT8 = ws + WS_ACT; E.mt = S.mt;
                pg8::gemm_phase<EpiGUMoe, SchedMoeGU, true>(lds + RING_OFF, S, E);
                SEAM(pb + 7);
            }
            if (PH_ON(11) && IN(pb + 8)) {
                unsigned char* ws = ws_of(args); PH_TID();
                SchedMoeDN S; S.A = (const char*)(ws + WS_ACT); S.W = (const char*)(ws + WS_WDE); S.mt.load((const unsigned*)(ws + WS_CTL) + CW_CNT); S.G = G; S.c = bx; S.skip_epi = args.flags & 1; S.ldaB = DFFE; S.ldbB = DFFE; S.KB = DFFE / 2;
                EpiDnMoe E; E.YP = (bf16*)(ws + WS_YP);
                pg8::gemm_phase<EpiDnMoe, SchedMoeDN, true>(lds + RING_OFF, S, E);
                SEAM(pb + 8);
            }
        }
    }
    if (PH_ON(12) && IN(19)) {
        unsigned char* ws = ws_of(args); PH_TID();
        MoeTiles mt; mt.load((const unsigned*)(ws + WS_CTL) + CW_CNT);
        final_phase((const bf16*)(ws + WS_XB), (const bf16*)(ws + WS_YP), (const int*)(ws + WS_TSLOT), (const float*)(ws + WS_TW), mt, in_of(args, 20), args.out, gw, NGW, lane);
    }
#undef IN
#undef SEAM
#undef LP_SETUP
#undef CONV_SLICE
#undef PH_TID
}

extern "C" void kernel_launch(void* const* d_in, const int* in_sizes, int n_in, void* d_out, int out_size, void* d_ws, size_t ws_size, hipStream_t stream) {
    static int grid = 0;
    if (grid == 0) {
        if (n_in != 21 || in_sizes[0] != T * D || out_size != T * D || ws_size < WS_END) { fprintf(stderr, "kernel_launch: unexpected shapes (n_in %d, in0 %d, out %d, ws %zu < %zu); nothing launched\n", n_in, n_in > 0 ? in_sizes[0] : -1, out_size, ws_size, (size_t)WS_END); grid = -1; return; }
        int dev = 0, cus = 0, per_cu = 0;
        if (hipGetDevice(&dev) != hipSuccess || hipDeviceGetAttribute(&cus, hipDeviceAttributeMultiprocessorCount, dev) != hipSuccess) { grid = -1; return; }
        if (hipFuncSetAttribute((const void*)trunk_fwd, hipFuncAttributeMaxDynamicSharedMemorySize, LDS_BYTES) != hipSuccess) { fprintf(stderr, "kernel_launch: hipFuncSetAttribute failed\n"); grid = -1; return; }
        if (hipOccupancyMaxActiveBlocksPerMultiprocessor(&per_cu, (const void*)trunk_fwd, NWAVES * 64, LDS_BYTES) != hipSuccess || per_cu < 1) { fprintf(stderr, "kernel_launch: occupancy query says %d blocks per CU\n", per_cu); }
        (void)hipGetLastError();
        grid = cus;
    }
    if (grid < 0) return;
    if (hipMemsetAsync((char*)d_ws + WS_CTL, 0, CTL_ZERO_BYTES, stream) != hipSuccess) return;
    Args a{};
    for (int i = 0; i < 21; ++i) a.in[i] = (const float*)d_in[i];
    a.out = (float*)d_out; a.ws = (unsigned char*)d_ws;
#if MK_SPLIT
    for (int p = 0; p < N_PHASES; ++p) {
        if (p == 9) continue;
        a.ph_lo = p; a.ph_hi = p + 1;
        hipLaunchKernelGGL(trunk_fwd, dim3(grid), dim3(NWAVES * 64), LDS_BYTES, stream, a);
    }
#else
    a.ph_lo = 0; a.ph_hi = N_PHASES;
    hipLaunchKernelGGL(trunk_fwd, dim3(grid), dim3(NWAVES * 64), LDS_BYTES, stream, a);
#ifdef PROBE_EXTRA
    { const int extra[] = {PROBE_EXTRA};
      for (int k = 0; k < (int)(sizeof(extra) / sizeof(extra[0])); ++k) { a.ph_lo = extra[k] & 255; a.ph_hi = (extra[k] & 255) + 1; a.flags = extra[k] >> 8; hipLaunchKernelGGL(trunk_fwd, dim3(grid), dim3(NWAVES * 64), LDS_BYTES, stream, a); } }
#endif
#endif
}
```

```cpp
#include <hip/hip_runtime.h>
#include <cstdio>
#include <cstdint>

#define GAS __attribute__((address_space(1)))
#define LAS __attribute__((address_space(3)))
typedef unsigned short bf16;
typedef unsigned v4u __attribute__((ext_vector_type(4)));
typedef unsigned v2u __attribute__((ext_vector_type(2)));
typedef float f32x4 __attribute__((ext_vector_type(4)));
typedef float f32x2 __attribute__((ext_vector_type(2)));
typedef short bf16x8 __attribute__((ext_vector_type(8)));
typedef short s16x4 __attribute__((ext_vector_type(4)));
typedef GAS unsigned gu32;
#define RLX_AGENT __ATOMIC_RELAXED, __HIP_MEMORY_SCOPE_AGENT
#define LDS_WAIT() asm volatile("s_waitcnt lgkmcnt(0)" ::: "memory")
#define VM_WAIT() asm volatile("s_waitcnt vmcnt(0)" ::: "memory")

typedef float f32x2_t __attribute__((ext_vector_type(2)));
typedef __bf16 bf16x2_t __attribute__((ext_vector_type(2)));
__device__ __forceinline__ unsigned cvt_pk_bf16(float lo, float hi) { const f32x2_t v = {lo, hi}; return __builtin_bit_cast(unsigned, __builtin_convertvector(v, bf16x2_t)); }
__device__ __forceinline__ bf16 f2bf(float f) { return (bf16)(cvt_pk_bf16(f, 0.f) & 0xffffu); }
__device__ __forceinline__ float bf2f(bf16 b) { return __uint_as_float(((unsigned)b) << 16); }
__device__ __forceinline__ float bflo(unsigned w) { return __uint_as_float(w << 16); }
__device__ __forceinline__ float bfhi(unsigned w) { return __uint_as_float(w & 0xffff0000u); }
__device__ __forceinline__ float fast_exp(float x) { return __builtin_amdgcn_exp2f(x * 1.4426950408889634f); }
__device__ __forceinline__ float fast_log(float x) { return __builtin_amdgcn_logf(x) * 0.6931471805599453f; }
__device__ __forceinline__ float clampf(float x, float lo, float hi) { return __builtin_fminf(__builtin_fmaxf(x, lo), hi); }
__device__ __forceinline__ float sigmoidf_(float x) { return __builtin_amdgcn_rcpf(1.0f + fast_exp(-clampf(x, -80.f, 80.f))); }
__device__ __forceinline__ float siluf_(float x) { return x * sigmoidf_(x); }
constexpr float NLOG2E = -1.4426950408889634f;
__device__ __forceinline__ unsigned pack4_u8(const f32x4& s) { unsigned w = 0;
    w = __builtin_amdgcn_cvt_pk_u8_f32(__builtin_fmaxf(__builtin_rintf(s[0] * 255.f), 1.f), 0, w); w = __builtin_amdgcn_cvt_pk_u8_f32(__builtin_fmaxf(__builtin_rintf(s[1] * 255.f), 1.f), 1, w);
    w = __builtin_amdgcn_cvt_pk_u8_f32(__builtin_fmaxf(__builtin_rintf(s[2] * 255.f), 1.f), 2, w); w = __builtin_amdgcn_cvt_pk_u8_f32(__builtin_fmaxf(__builtin_rintf(s[3] * 255.f), 1.f), 3, w); return w; }
__device__ __forceinline__ f32x4 unpack4_u8(unsigned w) { return (f32x4){(float)(w & 0xffu), (float)((w >> 8) & 0xffu), (float)((w >> 16) & 0xffu), (float)(w >> 24)}; }
__device__ __forceinline__ float sig_pre(float t) { return __builtin_amdgcn_rcpf(1.0f + __builtin_amdgcn_exp2f(t)); }
__device__ __forceinline__ float wave_sum(float v) {
#pragma unroll
    for (int o = 1; o < 64; o <<= 1) v += __shfl_xor(v, o);
    return v;
}

constexpr int RING_BYTES_FWD = 131072;
namespace pg8 {
constexpr int BM = 256, BK = 64, HALF = 128, HTB = HALF * BK * 2  , STAGE_BYTES = 8 * HTB, NXCD = 8, WGM = 8;
__host__ __device__ __forceinline__ int lds_byte(int r, int c) { const int st = (r >> 4) * 2 + (c >> 5), rr = r & 15, cc = c & 31, ob = rr * 64 + cc * 2; return st * 1024 + (ob ^ (((ob >> 9) & 1) << 5)); }
__host__ __device__ __forceinline__ void stage_rc(int b, int& R, int& C) { const int st = b / 1024, sb = b % 1024, swz = sb ^ (((sb >> 9) & 1) << 5); R = (st >> 1) * 16 + swz / 64; C = (st & 1) * 32 + (swz % 64) / 2; }
__host__ __device__ __forceinline__ int perm32(int rho) { const int n = rho >> 4, i = rho & 15; return 8 * (i >> 2) + 4 * n + (i & 3); }

struct Unit { int pm, pn, aux; };

__device__ __forceinline__ bool tile_order(long L, int nM, int nN, int& pm, int& pn) {
    const int nwg = nM * nN; if (L >= nwg) return false;
    int wgid = (int)L; { const int q = nwg / NXCD, r = nwg % NXCD, xcd = wgid % NXCD, off = wgid / NXCD; wgid = (xcd < r ? xcd * (q + 1) : r * (q + 1) + (xcd - r) * q) + off; }
    const int nig = WGM * nN, gid = wgid / nig, fm = gid * WGM, gsz = (nM - fm) < WGM ? (nM - fm) : WGM;
    pm = fm + ((wgid % nig) % gsz); pn = (wgid % nig) / gsz; return true;
}

__device__ __forceinline__ const char* uni_ptr(const char* p) { const unsigned long long v = (unsigned long long)p;
    return (const char*)(((unsigned long long)(unsigned)__builtin_amdgcn_readfirstlane((int)(v >> 32)) << 32) | (unsigned)__builtin_amdgcn_readfirstlane((int)v)); }
__device__ __forceinline__ void glds16_s(const char* sbase, unsigned voff, unsigned lds_addr) {
    unsigned sv;
    asm volatile("s_mov_b32 %0, m0\n\ts_mov_b32 m0, %3\n\ts_nop 0\n\tglobal_load_lds_dwordx4 %1, %2\n\ts_mov_b32 m0, %0" : "=&s"(sv) : "v"(voff), "s"(sbase), "s"(lds_addr) : "memory");
}
typedef f32x4 Acc[2][2][4][2];
typedef int i32x4v __attribute__((ext_vector_type(4)));
typedef int i32x8v __attribute__((ext_vector_type(8)));
__device__ __forceinline__ i32x8v cat8(const bf16x8& a, const bf16x8& b) { return __builtin_shufflevector(__builtin_bit_cast(i32x4v, a), __builtin_bit_cast(i32x4v, b), 0, 1, 2, 3, 4, 5, 6, 7); }
__device__ __forceinline__ void mfma8z(f32x4& acc, const i32x8v& a, const i32x8v& b) { asm volatile("v_mfma_f32_16x16x128_f8f6f4 %0, %1, %2, 0" : "=&v"(acc) : "v"(a), "v"(b)); }
__device__ __forceinline__ void mfma8(f32x4& acc, const i32x8v& a, const i32x8v& b) { asm volatile("v_mfma_f32_16x16x128_f8f6f4 %0, %1, %2, %0" : "+v"(acc) : "v"(a), "v"(b)); }
__device__ __forceinline__ void mfma8_drain(f32x4 (&acc)[2][2][4][2]) {
    asm volatile("s_nop 15\n\ts_nop 15" : "+v"(acc[0][0][0][0]), "+v"(acc[0][0][0][1]), "+v"(acc[0][0][1][0]), "+v"(acc[0][0][1][1]), "+v"(acc[0][0][2][0]), "+v"(acc[0][0][2][1]), "+v"(acc[0][0][3][0]), "+v"(acc[0][0][3][1]),
                 "+v"(acc[0][1][0][0]), "+v"(acc[0][1][0][1]), "+v"(acc[0][1][1][0]), "+v"(acc[0][1][1][1]), "+v"(acc[0][1][2][0]), "+v"(acc[0][1][2][1]), "+v"(acc[0][1][3][0]), "+v"(acc[0][1][3][1]) :: "memory");
    asm volatile("" : "+v"(acc[1][0][0][0]), "+v"(acc[1][0][0][1]), "+v"(acc[1][0][1][0]), "+v"(acc[1][0][1][1]), "+v"(acc[1][0][2][0]), "+v"(acc[1][0][2][1]), "+v"(acc[1][0][3][0]), "+v"(acc[1][0][3][1]),
                 "+v"(acc[1][1][0][0]), "+v"(acc[1][1][0][1]), "+v"(acc[1][1][1][0]), "+v"(acc[1][1][1][1]), "+v"(acc[1][1][2][0]), "+v"(acc[1][1][2][1]), "+v"(acc[1][1][3][0]), "+v"(acc[1][1][3][1]) :: "memory");
}

template <class Epi, class Sched, bool ALIGN_EPI>
__device__ __forceinline__ void gemm_phase(LAS unsigned char* lds, const Sched& S, const Epi& E) {
    int tid_ = threadIdx.x; asm volatile("" : "+v"(tid_));
    const int tid = tid_, wid = __builtin_amdgcn_readfirstlane(tid >> 6), lane = tid & 63, wr = wid >> 2, wc = wid & 3, fr = lane & 15, fq = lane >> 4;
    const int nt = S.KB / 128;
    int Rr[2], Cc[2]; unsigned voffB[2], voffA[2][2], nvoffA[2][2];
#pragma unroll
    for (int i = 0; i < 2; ++i) { stage_rc(tid * 16 + i * 8192, Rr[i], Cc[i]); const int Rb = Epi::PERM ? ((Rr[i] & ~31) + perm32(Rr[i] & 31)) : Rr[i];
        voffB[i] = (unsigned)(Rb * S.ldbB + Cc[i] * 2);
        voffA[0][i] = (unsigned)(Rr[i] * S.ldaB + Cc[i] * 2); voffA[1][i] = (unsigned)((Rr[i] + HALF) * S.ldaB + Cc[i] * 2); nvoffA[0][i] = voffA[0][i]; nvoffA[1][i] = voffA[1][i]; }
    const size_t kstep = (size_t)128;
    const size_t hstepB = (size_t)HALF * S.ldbB;
    const unsigned ldsb = (unsigned)__builtin_amdgcn_readfirstlane((int)((unsigned)(uintptr_t)lds + (unsigned)wid * 1024u));
    const int aoff = lds_byte(wr * 64 + fr, fq * 8), boff = lds_byte(wc * 32 + fr, fq * 8);
#define PG8_SA(b, h) (((b) * 2 + (h)) * HTB)
#define PG8_SB(b, h) ((4 + (b) * 2 + (h)) * HTB)
#define PG8_STAGE(bufoff, gbase, voff) do { _Pragma("unroll") for (int _i = 0; _i < 2; ++_i) glds16_s((gbase), (voff)[_i], ldsb + (unsigned)((bufoff) + _i * 8192)); } while (0)
#define PG8_LDA(dst, b, h) do { _Pragma("unroll") for (int m = 0; m < 4; ++m) _Pragma("unroll") for (int k = 0; k < 2; ++k) dst[m][k] = *(const LAS bf16x8*)(lds + PG8_SA(b, h) + aoff + m * 2048 + k * 1024); } while (0)
#define PG8_LDB(dst, b, h) do { _Pragma("unroll") for (int n = 0; n < 2; ++n) _Pragma("unroll") for (int k = 0; k < 2; ++k) dst[n][k] = *(const LAS bf16x8*)(lds + PG8_SB(b, h) + boff + n * 2048 + k * 1024); } while (0)
#define PG8_MMA(ai, bj, At, Bt) do { __builtin_amdgcn_s_setprio(1); _Pragma("unroll") for (int m = 0; m < 4; ++m) _Pragma("unroll") for (int n = 0; n < 2; ++n) { \
        if constexpr (Sched::FP8) { mfma8(acc[ai][bj][m][n], cat8(Bt[n][0], Bt[n][1]), cat8(At[m][0], At[m][1])); } \
        else { _Pragma("unroll") for (int k = 0; k < 2; ++k) acc[ai][bj][m][n] = __builtin_amdgcn_mfma_f32_16x16x32_bf16(Bt[n][k], At[m][k], acc[ai][bj][m][n], 0, 0, 0); } } \
        __builtin_amdgcn_s_setprio(0); } while (0)
#define PG8_MMA_Z(ai, bj, At, Bt) do { __builtin_amdgcn_s_setprio(1); _Pragma("unroll") for (int m = 0; m < 4; ++m) _Pragma("unroll") for (int n = 0; n < 2; ++n) { \
        if constexpr (Sched::FP8) { mfma8z(acc[ai][bj][m][n], cat8(Bt[n][0], Bt[n][1]), cat8(At[m][0], At[m][1])); } \
        else { acc[ai][bj][m][n] = __builtin_amdgcn_mfma_f32_16x16x32_bf16(Bt[n][0], At[m][0], (f32x4){0.f, 0.f, 0.f, 0.f}, 0, 0, 0); \
               acc[ai][bj][m][n] = __builtin_amdgcn_mfma_f32_16x16x32_bf16(Bt[n][1], At[m][1], acc[ai][bj][m][n], 0, 0, 0); } } \
        __builtin_amdgcn_s_setprio(0); } while (0)
#define PG8_WAIT_V(n) asm volatile("s_waitcnt vmcnt(" #n ")" ::: "memory")
#define PG8_WAIT_L(n) asm volatile("s_waitcnt lgkmcnt(" #n ")" ::: "memory")
#define PG8_BAR __builtin_amdgcn_s_barrier()
#define PG8_SCHED __builtin_amdgcn_sched_barrier(0)
#define PG8_KBODY(t, MMAF) do { \
            const bool last = (t == nt - 2); \
            const char* a1 = cA + (size_t)(t + 1) * kstep; \
            const char* a2 = last ? nA : cA + (size_t)(t + 2) * kstep; const char* b2 = last ? nB : cB + (size_t)(t + 2) * kstep; \
            const char* a3 = a2 + kstep; const char* b3 = b2 + kstep; \
            unsigned o2[2][2]; \
            _Pragma("unroll") \
            for (int h = 0; h < 2; ++h) \
            _Pragma("unroll") \
                for (int i = 0; i < 2; ++i) o2[h][i] = (Sched::GATHER && last) ? nvoffA[h][i] : voffA[h][i]; \
            PG8_LDB(B0, 0, 0); PG8_LDB(B1, 0, 1); PG8_SCHED; PG8_LDA(At, 0, 0); PG8_STAGE(PG8_SA(1, 1), a1, voffA[1]); \
            PG8_WAIT_V(8); PG8_WAIT_L(0); PG8_BAR; MMAF(0, 0, At, B0); MMAF(0, 1, At, B1); PG8_BAR; PG8_SCHED; \
            PG8_LDA(At, 0, 1); PG8_STAGE(PG8_SB(0, 0), b2, voffB); PG8_STAGE(PG8_SB(0, 1), b2 + hstepB, voffB); PG8_STAGE(PG8_SA(0, 0), a2, o2[0]); \
            PG8_WAIT_V(8); PG8_WAIT_L(0); PG8_BAR; MMAF(1, 0, At, B0); MMAF(1, 1, At, B1); PG8_BAR; PG8_SCHED; \
            PG8_LDB(B0, 1, 0); PG8_LDB(B1, 1, 1); PG8_SCHED; PG8_LDA(At, 1, 0); PG8_STAGE(PG8_SA(0, 1), a2, o2[1]); \
            PG8_WAIT_V(8); PG8_WAIT_L(0); PG8_BAR; PG8_MMA(0, 0, At, B0); PG8_MMA(0, 1, At, B1); PG8_BAR; PG8_SCHED; \
            PG8_LDA(At, 1, 1); PG8_STAGE(PG8_SB(1, 0), b3, voffB); PG8_STAGE(PG8_SB(1, 1), b3 + hstepB, voffB); PG8_STAGE(PG8_SA(1, 0), a3, o2[0]); \
            PG8_WAIT_V(8); PG8_WAIT_L(0); PG8_BAR; PG8_MMA(1, 0, At, B0); PG8_MMA(1, 1, At, B1); PG8_BAR; PG8_SCHED; \
        } while (0)
    Unit cur, nxt; int ui = 0;
    if (!S.next(0, cur)) return;
    Acc acc;
#pragma unroll
    for (int a = 0; a < 2; ++a)
#pragma unroll
        for (int b = 0; b < 2; ++b)
#pragma unroll
            for (int m = 0; m < 4; ++m)
#pragma unroll
                for (int n = 0; n < 2; ++n) acc[a][b][m][n] = (f32x4){0.f, 0.f, 0.f, 0.f};
    bf16x8 At[4][2], B0[2][2], B1[2][2];
    const char* cA = uni_ptr(S.a_base(cur)); const char* cB = uni_ptr(S.b_base(cur));
    if constexpr (Sched::GATHER) S.a_offs(cur, Rr, Cc, voffA);
    PG8_STAGE(PG8_SB(0, 0), cB, voffB); PG8_STAGE(PG8_SB(0, 1), cB + hstepB, voffB); PG8_STAGE(PG8_SA(0, 0), cA, voffA[0]); PG8_STAGE(PG8_SA(0, 1), cA, voffA[1]);
    if (wr == 1) PG8_BAR;
    PG8_WAIT_V(2); PG8_BAR;
    PG8_STAGE(PG8_SB(1, 0), cB + kstep, voffB); PG8_STAGE(PG8_SA(1, 0), cA + kstep, voffA[0]); PG8_STAGE(PG8_SB(1, 1), cB + hstepB + kstep, voffB);
    PG8_WAIT_V(6); PG8_BAR;
    for (;;) {
        const bool has_next = S.next(ui + 1, nxt);
        const char* nA = uni_ptr(has_next ? S.a_base(nxt) : cA); const char* nB = uni_ptr(has_next ? S.b_base(nxt) : cB);
        if constexpr (Sched::GATHER) { if (has_next) S.a_offs(nxt, Rr, Cc, nvoffA); else {
#pragma unroll
            for (int i = 0; i < 2; ++i) { nvoffA[0][i] = voffA[0][i]; nvoffA[1][i] = voffA[1][i]; } } }
        if constexpr (Epi::ZERO_RESET) { PG8_KBODY(0, PG8_MMA_Z); for (int t = 2; t < nt; t += 2) PG8_KBODY(t, PG8_MMA); }
        else { for (int t = 0; t < nt; t += 2) PG8_KBODY(t, PG8_MMA); }
        if constexpr (Sched::FP8) mfma8_drain(acc);
        if constexpr (ALIGN_EPI) { if (wr == 0) PG8_BAR; }
        {
          int tz = threadIdx.x; asm volatile("" : "+v"(tz)); const int wz = __builtin_amdgcn_readfirstlane(tz >> 6), lz = tz & 63;
          if (!S.skip_epi) E(acc, cur, wz >> 2, wz & 3, lz & 15, lz >> 4);
          if (!has_next) break;
          if constexpr (!Epi::ZERO_RESET) E.reset(acc, cur, wz >> 2, wz & 3, lz & 15, lz >> 4); }
        cur = nxt; cA = nA; cB = nB; ++ui;
        if constexpr (Sched::GATHER) {
#pragma unroll
            for (int i = 0; i < 2; ++i) { voffA[0][i] = nvoffA[0][i]; voffA[1][i] = nvoffA[1][i]; } }
        if constexpr (ALIGN_EPI) { if (wr == 1) PG8_BAR; }
    }
    PG8_WAIT_V(0);
    if constexpr (!ALIGN_EPI) { if (wr == 0) PG8_BAR; }
    PG8_BAR;
#undef PG8_KBODY
#undef PG8_MMA_Z
#undef PG8_SA
#undef PG8_SB
#undef PG8_STAGE
#undef PG8_LDA
#undef PG8_LDB
#undef PG8_MMA
#undef PG8_WAIT_V
#undef PG8_WAIT_L
#undef PG8_BAR
#undef PG8_SCHED
}
}
constexpr int T = 8192, D = 2048, DEPTH = 2;
constexpr int NIN_BF = 30;
constexpr int NIN = 11776;
constexpr int DIN_SRC = 11280;
constexpr int DFF = 5632, DFFE = 7168, NE = 8;
constexpr int QK_LD = 1536, V_LD = 2048, M_LD = 4096;
constexpr int NCH = 128, CH = 64, NHEADS = 12;
constexpr int STATE_E = 262144;
constexpr float EPS = 1e-6f;
constexpr float QSCALE = 0.08838834764831845f;
constexpr int MOE_CAP = 8192;
constexpr int MOE_MAXT = 72;

template <bool F8> struct SchedDenseT {
    static constexpr bool GATHER = false, FP8 = F8;
    const char* A; const char* Bt; int nM, nN, G, c, ldaB, ldbB, KB, skip_epi;
    __device__ __forceinline__ void shape(int lda, int K) { const int es = F8 ? 1 : 2; ldaB = lda * es; ldbB = K * es; KB = K * es; }
    __device__ __forceinline__ bool next(int i, pg8::Unit& u) const { u.aux = i; return pg8::tile_order((long)i * G + c, nM, nN, u.pm, u.pn); }
    __device__ __forceinline__ const char* a_base(const pg8::Unit& u) const { return A + (size_t)u.pm * 256 * ldaB; }
    __device__ __forceinline__ const char* b_base(const pg8::Unit& u) const { return Bt + (size_t)u.pn * 256 * ldbB; }
    __device__ __forceinline__ void a_offs(const pg8::Unit&, const int (&)[2], const int (&)[2], unsigned (&)[2][2]) const {}
};
typedef SchedDenseT<false> SchedDense;
typedef SchedDenseT<true> SchedDense8;
struct SchedProj {
    static constexpr bool GATHER = false, FP8 = false;
    const char* Y; const char* Wa; const char* Wb; int G, c, ldaB, ldbB, KB, skip_epi;
    __device__ __forceinline__ bool next(int i, pg8::Unit& u) const { u.aux = i & 1; return pg8::tile_order((long)(i >> 1) * G + c, T / 256, D / 256, u.pm, u.pn); }
    __device__ __forceinline__ const char* a_base(const pg8::Unit& u) const { return Y + (size_t)u.pm * 256 * ldaB + (u.aux ? 1024 * 2 : 0); }
    __device__ __forceinline__ const char* b_base(const pg8::Unit& u) const { return (u.aux ? Wb : Wa) + (size_t)u.pn * 256 * ldbB; }
    __device__ __forceinline__ void a_offs(const pg8::Unit&, const int (&)[2], const int (&)[2], unsigned (&)[2][2]) const {}
};
typedef int i32x8 __attribute__((ext_vector_type(8)));
struct MoeTiles {
    i32x8 cnt, tb; int ntiles;
    __device__ __forceinline__ void load(const unsigned* counts_) {
        int s = 0;
#pragma unroll
        for (int e = 0; e < NE; ++e) { int c = (int)__hip_atomic_load((unsigned*)counts_ + e, RLX_AGENT); c = c < 0 ? 0 : (c > MOE_CAP ? MOE_CAP : c); c = __builtin_amdgcn_readfirstlane(c); cnt[e] = c; tb[e] = s; s += (c + 255) >> 8; }
        ntiles = s;
    }
    __device__ __forceinline__ int expert_of(int pm) const {
        return (pm >= tb[1] ? 1 : 0) + (pm >= tb[2] ? 1 : 0) + (pm >= tb[3] ? 1 : 0) + (pm >= tb[4] ? 1 : 0) + (pm >= tb[5] ? 1 : 0) + (pm >= tb[6] ? 1 : 0) + (pm >= tb[7] ? 1 : 0); }
    __device__ __forceinline__ int cnt_of(int e) const { int c = cnt[0]; c = e == 1 ? cnt[1] : c; c = e == 2 ? cnt[2] : c; c = e == 3 ? cnt[3] : c; c = e == 4 ? cnt[4] : c; c = e == 5 ? cnt[5] : c; c = e == 6 ? cnt[6] : c; c = e == 7 ? cnt[7] : c; return c; }
    __device__ __forceinline__ int tb_of(int e) const { int c = tb[0]; c = e == 1 ? tb[1] : c; c = e == 2 ? tb[2] : c; c = e == 3 ? tb[3] : c; c = e == 4 ? tb[4] : c; c = e == 5 ? tb[5] : c; c = e == 6 ? tb[6] : c; c = e == 7 ? tb[7] : c; return c; }
};
struct SchedMoeGU {
    static constexpr bool GATHER = true, FP8 = true;
    const char* X8; const char* W; const int* list; MoeTiles mt; int G, c, ldaB, ldbB, KB, skip_epi;
    __device__ __forceinline__ bool next(int i, pg8::Unit& u) const {
        if (!pg8::tile_order((long)i * G + c, mt.ntiles, (2 * DFFE) / 256, u.pm, u.pn)) return false;
        const int e = mt.expert_of(u.pm); u.aux = e | ((u.pm - mt.tb_of(e)) << 8); return true; }
    __device__ __forceinline__ const char* a_base(const pg8::Unit&) const { return X8; }
    __device__ __forceinline__ const char* b_base(const pg8::Unit& u) const { return W + (size_t)(u.aux & 255) * ((size_t)2 * DFFE * D) + (size_t)u.pn * 256 * ldbB; }
    __device__ __forceinline__ void a_offs(const pg8::Unit& u, const int (&R)[2], const int (&C)[2], unsigned (&voff)[2][2]) const {
        const int e = u.aux & 255, lt = u.aux >> 8, n = mt.cnt_of(e);
        int tk[2][2];
#pragma unroll
        for (int h = 0; h < 2; ++h)
#pragma unroll
            for (int i = 0; i < 2; ++i) { const int pos = lt * 256 + h * 128 + R[i]; tk[h][i] = list[e * MOE_CAP + (pos < n ? pos : 0)]; }
        asm volatile("" : "+v"(tk[0][0]), "+v"(tk[0][1]), "+v"(tk[1][0]), "+v"(tk[1][1]));
#pragma unroll
        for (int h = 0; h < 2; ++h)
#pragma unroll
            for (int i = 0; i < 2; ++i) { const int pos = lt * 256 + h * 128 + R[i]; const int tok = pos < n ? tk[h][i] : 0; voff[h][i] = (unsigned)(tok * D + C[i] * 2); }
    }
};
struct SchedMoeDN {
    static constexpr bool GATHER = false, FP8 = true;
    const char* A; const char* W; MoeTiles mt; int G, c, ldaB, ldbB, KB, skip_epi;
    __device__ __forceinline__ bool next(int i, pg8::Unit& u) const {
        int pn2; if (!pg8::tile_order((long)i * G + c, mt.ntiles, 2 * (D / 256), u.pm, pn2)) return false;
        u.pn = pn2 >> 1; u.aux = mt.expert_of(u.pm) | ((pn2 & 1) << 8); return true; }
    __device__ __forceinline__ const char* a_base(const pg8::Unit& u) const { return A + (size_t)u.pm * 256 * ldaB + (size_t)(u.aux >> 8) * KB; }
    __device__ __forceinline__ const char* b_base(const pg8::Unit& u) const { return W + (size_t)(u.aux & 255) * ((size_t)D * DFFE) + (size_t)u.pn * 256 * ldbB + (size_t)(u.aux >> 8) * KB; }
    __device__ __forceinline__ void a_offs(const pg8::Unit&, const int (&)[2], const int (&)[2], unsigned (&)[2][2]) const {}
};

__device__ __forceinline__ void acc_zero(pg8::Acc& acc) {
#pragma unroll
    for (int a = 0; a < 2; ++a)
#pragma unroll
        for (int b = 0; b < 2; ++b)
#pragma unroll
            for (int m = 0; m < 4; ++m)
#pragma unroll
                for (int n = 0; n < 2; ++n) acc[a][b][m][n] = (f32x4){0.f, 0.f, 0.f, 0.f};
}
__device__ __forceinline__ v4u pack8(const f32x4& a, const f32x4& b) { v4u w; w.x = cvt_pk_bf16(a[0], a[1]); w.y = cvt_pk_bf16(a[2], a[3]); w.z = cvt_pk_bf16(b[0], b[1]); w.w = cvt_pk_bf16(b[2], b[3]); return w; }

__device__ __forceinline__ float row_scale(const float* rsp, size_t row) {
    const f32x4 a = *(const f32x4*)(rsp + row * 8), b = *(const f32x4*)(rsp + row * 8 + 4);
    return __builtin_amdgcn_rsqf((((a[0] + a[1]) + (a[2] + a[3])) + ((b[0] + b[1]) + (b[2] + b[3]))) * (1.0f / D) + EPS);
}
constexpr float W8_SCALE = 64.f, ACT8_SCALE = 16.f;
__device__ __forceinline__ float clamp8(float x) { return __builtin_fminf(__builtin_fmaxf(x, -448.f), 448.f); }
__device__ __forceinline__ unsigned pack4_fp8(float a, float b, float c, float d) { int w = 0; w = __builtin_amdgcn_cvt_pk_fp8_f32(clamp8(a), clamp8(b), w, false); w = __builtin_amdgcn_cvt_pk_fp8_f32(clamp8(c), clamp8(d), w, true); return (unsigned)w; }
constexpr float X8_SCALE = 4.f;
struct RowScales { float v[8]; };
constexpr int RST_OFF = RING_BYTES_FWD + 6144;
template <class Sched> __device__ __forceinline__ void stage_row_scales(LAS unsigned char* lds, const Sched& S, const float* rsp, int tid) {
    LAS float* tab = (LAS float*)(lds + RST_OFF);
    if (tid < 256) { f32x4 a[6], b[6];
#pragma unroll
        for (int i = 0; i < 6; ++i) { pg8::Unit u; const bool ok = S.next(i, u); const size_t row = (size_t)((ok ? u.pm : 0) * 256 + tid); a[i] = *(const f32x4*)(rsp + row * 8); b[i] = *(const f32x4*)(rsp + row * 8 + 4); }
#pragma unroll
        for (int i = 0; i < 6; ++i) tab[i * 256 + tid] = __builtin_amdgcn_rsqf((((a[i][0] + a[i][1]) + (a[i][2] + a[i][3])) + ((b[i][0] + b[i][1]) + (b[i][2] + b[i][3]))) * (1.0f / D) + EPS); }
    __syncthreads();
}
__device__ __forceinline__ void row_scales8_lds(RowScales& R, LAS const float* tab, const pg8::Unit& u, int row0) {
    const int base = u.aux * 256 + (row0 - u.pm * 256);
#pragma unroll
    for (int g = 0; g < 8; ++g) R.v[g] = tab[base + (g >> 2) * 128 + (g & 3) * 16];
}
__device__ __forceinline__ void row_scales8(RowScales& R, const float* rsp, int row0) {
#pragma unroll
    for (int h = 0; h < 2; ++h) { f32x4 a[4], b[4];
#pragma unroll
        for (int g = 0; g < 4; ++g) { const size_t row = (size_t)(row0 + h * 128 + g * 16); a[g] = *(const f32x4*)(rsp + row * 8); b[g] = *(const f32x4*)(rsp + row * 8 + 4); }
#pragma unroll
        for (int g = 0; g < 4; ++g) R.v[4 * h + g] = __builtin_amdgcn_rsqf((((a[g][0] + a[g][1]) + (a[g][2] + a[g][3])) + ((b[g][0] + b[g][1]) + (b[g][2] + b[g][3]))) * (1.0f / D) + EPS);
        asm volatile("" ::: "memory"); }
}
struct EpiIn {
    static constexpr bool PERM = true, ZERO_RESET = false;
    const float* rsq;
    LAS const float* rst;
    bf16 *Q, *Kb, *V, *SG, *M; float* Gf; const float* lbv; const float* gkb;
    __device__ __forceinline__ void operator()(const pg8::Acc& acc, const pg8::Unit& u, int wr, int wc, int fr, int fq) const {
        const int pn = u.pn, row0 = u.pm * 256 + wr * 64 + fr, cl = wc * 32 + 8 * fq;
        int mode, ld, col0; int sel; float sc = 1.f;
        if (pn < 4)       { mode = 0; sel = 0; ld = QK_LD; col0 = 256 * pn; sc = QSCALE; }
        else if (pn < 8)  { mode = 3; sel = 1; ld = QK_LD; col0 = 256 * (pn - 4); }
        else if (pn < 12) { mode = 0; sel = 2; ld = V_LD;  col0 = 256 * (pn - 8); }
        else if (pn < 16) { mode = 1; sel = 3; ld = V_LD;  col0 = 256 * (pn - 12); }
        else if (pn < 18) { mode = 0; sel = 0; ld = QK_LD; col0 = 1024 + 256 * (pn - 16); sc = QSCALE; }
        else if (pn < 20) { mode = 0; sel = 1; ld = QK_LD; col0 = 1024 + 256 * (pn - 18); }
        else if (pn < 24) { mode = 0; sel = 2; ld = V_LD;  col0 = 1024 + 256 * (pn - 20); }
        else if (pn < 28) { mode = 1; sel = 3; ld = V_LD;  col0 = 1024 + 256 * (pn - 24); }
        else              { mode = 4; sel = 0; ld = QK_LD; col0 = 1024 + 256 * (pn - 28); }
        const size_t doff = sel == 0 ? (size_t)0 : sel == 1 ? (size_t)((const char*)Kb - (const char*)Q) : sel == 2 ? (size_t)((const char*)V - (const char*)Q) : (size_t)((const char*)SG - (const char*)Q);
        bf16* dst = (bf16*)((char*)Q + doff);
        RowScales RS; row_scales8_lds(RS, rst, u, row0);
#define RS_AT(ai, m) RS.v[(ai) * 4 + (m)]
        if (mode <= 1) {
#pragma unroll
            for (int ai = 0; ai < 2; ++ai)
#pragma unroll
                for (int m = 0; m < 4; ++m) { const float r = RS_AT(ai, m) * sc, nr = r * NLOG2E; bf16* rowp = dst + (size_t)(row0 + ai * 128 + m * 16) * ld + col0 + cl;
#pragma unroll
                    for (int bj = 0; bj < 2; ++bj) { f32x4 v0 = acc[ai][bj][m][0] * r, v1 = acc[ai][bj][m][1] * r;
                        if (mode == 1) { const f32x4 t0 = acc[ai][bj][m][0] * nr, t1 = acc[ai][bj][m][1] * nr;
#pragma unroll
                            for (int j = 0; j < 4; ++j) { v0[j] *= sig_pre(t0[j]); v1[j] *= sig_pre(t1[j]); } }
                        *(v4u*)(rowp + bj * 128) = pack8(v0, v1); } }
        } else if (mode == 3) {
#pragma unroll
            for (int bj = 0; bj < 2; ++bj) {
                const f32x4 lb0 = *(const f32x4*)(lbv + col0 + bj * 128 + cl), lb1 = *(const f32x4*)(lbv + col0 + bj * 128 + cl + 4); const f32x4 om0 = 1.f - lb0, om1 = 1.f - lb1;
#pragma unroll
                for (int ai = 0; ai < 2; ++ai)
#pragma unroll
                    for (int m = 0; m < 4; ++m) { const float nr = RS_AT(ai, m) * NLOG2E; const size_t ro = (size_t)(row0 + ai * 128 + m * 16) * QK_LD + col0 + bj * 128 + cl;
                        f32x4 g0, g1, k0, k1;
#pragma unroll
                        for (int j = 0; j < 4; ++j) {
                            { const float t = __builtin_amdgcn_exp2f(clampf(acc[ai][bj][m][0][j] * nr, -115.f, 115.f)), s = __builtin_amdgcn_rcpf(1.f + t), om = om0[j]; g0[j] = fast_log(__builtin_fmaf(om, s, lb0[j])); k0[j] = __builtin_fmaf(-om, s, om); }
                            { const float t = __builtin_amdgcn_exp2f(clampf(acc[ai][bj][m][1][j] * nr, -115.f, 115.f)), s = __builtin_amdgcn_rcpf(1.f + t), om = om1[j]; g1[j] = fast_log(__builtin_fmaf(om, s, lb1[j])); k1[j] = __builtin_fmaf(-om, s, om); } }
                        *(f32x4*)(Gf + ro) = g0; *(f32x4*)(Gf + ro + 4) = g1; *(v4u*)(Kb + ro) = pack8(k0, k1); } }
        } else {
#pragma unroll
            for (int bj = 0; bj < 2; ++bj) {
                const f32x4 b0 = *(const f32x4*)(gkb + (col0 - 1024) + bj * 128 + cl), b1 = *(const f32x4*)(gkb + (col0 - 1024) + bj * 128 + cl + 4);
#pragma unroll
                for (int ai = 0; ai < 2; ++ai)
#pragma unroll
                    for (int m = 0; m < 4; ++m) { const float r = RS_AT(ai, m); const size_t ro = (size_t)(row0 + ai * 128 + m * 16) * QK_LD + col0 + bj * 128 + cl;
                        f32x4 g0, g1;
#pragma unroll
                        for (int j = 0; j < 4; ++j) {
                            { const float z = clampf(acc[ai][bj][m][0][j] * r + b0[j], -80.f, 80.f); g0[j] = -fast_log(1.f + fast_exp(-z)) * (1.f / 16.f); }
                            { const float z = clampf(acc[ai][bj][m][1][j] * r + b1[j], -80.f, 80.f); g1[j] = -fast_log(1.f + fast_exp(-z)) * (1.f / 16.f); } }
                        *(f32x4*)(Gf + ro) = g0; *(f32x4*)(Gf + ro + 4) = g1; } }
        }
    }
    __device__ __forceinline__ void reset(pg8::Acc& acc, const pg8::Unit&, int, int, int, int) const { acc_zero(acc); }
};

struct EpiIn8 {
    static constexpr bool PERM = true, ZERO_RESET = false;
    const float* rsq; unsigned char* M; LAS const float* rst;
    __device__ __forceinline__ void operator()(const pg8::Acc& acc, const pg8::Unit& u, int wr, int wc, int fr, int fq) const {
        const int row0 = u.pm * 256 + wr * 64 + fr, col0 = u.pn * 256 + wc * 32 + 8 * fq;
        RowScales RS; row_scales8_lds(RS, rst, u, row0);
#pragma unroll
        for (int ai = 0; ai < 2; ++ai)
#pragma unroll
            for (int m = 0; m < 4; ++m) { const size_t r = (size_t)(row0 + ai * 128 + m * 16); const float rs = RS.v[ai * 4 + m] * (NLOG2E / (W8_SCALE * X8_SCALE));
#pragma unroll
                for (int bj = 0; bj < 2; ++bj) { f32x4 v0 = acc[ai][bj][m][0] * rs, v1 = acc[ai][bj][m][1] * rs;
#pragma unroll
                    for (int j = 0; j < 4; ++j) { v0[j] = sig_pre(v0[j]); v1[j] = sig_pre(v1[j]); }
                    v2u w; w.x = pack4_u8(v0); w.y = pack4_u8(v1); *(v2u*)(M + r * M_LD + col0 + bj * 128) = w; }
                asm volatile("" ::: "memory"); }
    }
    __device__ __forceinline__ void reset(pg8::Acc& acc, const pg8::Unit&, int, int, int, int) const { acc_zero(acc); }
};
struct EpiProj {
    static constexpr bool PERM = true, ZERO_RESET = false;
    const unsigned char* M; bf16* MG;
    __device__ __forceinline__ void operator()(const pg8::Acc& acc, const pg8::Unit& u, int wr, int wc, int fr, int fq) const {
        if (u.aux == 0) return;
        const int row0 = u.pm * 256 + wr * 64 + fr, col0 = u.pn * 256 + wc * 32 + 8 * fq;
        v2u ngb[2], ngb2[2];
#pragma unroll
        for (int bj = 0; bj < 2; ++bj) { ngb[bj] = *(const v2u*)(M + (size_t)row0 * M_LD + 2048 + col0 + bj * 128); ngb2[bj] = *(const v2u*)(M + (size_t)(row0 + 16) * M_LD + 2048 + col0 + bj * 128); }
#pragma unroll
        for (int ai = 0; ai < 2; ++ai)
#pragma unroll
            for (int m = 0; m < 4; ++m) { const size_t r = (size_t)(row0 + ai * 128 + m * 16);
                v2u cgb[2]; cgb[0] = ngb[0]; cgb[1] = ngb[1]; ngb[0] = ngb2[0]; ngb[1] = ngb2[1];
                if (ai * 4 + m < 6) { const int gn = ai * 4 + m + 2; const size_t rn = (size_t)(row0 + (gn >> 2) * 128 + (gn & 3) * 16);
#pragma unroll
                    for (int bj = 0; bj < 2; ++bj) ngb2[bj] = *(const v2u*)(M + rn * M_LD + 2048 + col0 + bj * 128); }
#pragma unroll
                for (int bj = 0; bj < 2; ++bj) { const v2u gb = cgb[bj];
                    const f32x4 v0 = acc[ai][bj][m][0] * unpack4_u8(gb.x) * (1.0f / 255.f), v1 = acc[ai][bj][m][1] * unpack4_u8(gb.y) * (1.0f / 255.f);
                    *(v4u*)(MG + r * D + col0 + bj * 128) = pack8(v0, v1); }
                asm volatile("" ::: "memory"); }
    }
    __device__ __forceinline__ void reset(pg8::Acc& acc, const pg8::Unit& u, int wr, int wc, int fr, int fq) const {
        const float keep = u.aux == 0 ? 1.f : 0.f;
        const int row0 = u.pm * 256 + wr * 64 + fr, col0 = u.pn * 256 + wc * 32 + 8 * fq;
        v2u nga[2], ngb[2], nga2[2], ngb2[2];
#pragma unroll
        for (int bj = 0; bj < 2; ++bj) { nga[bj] = *(const v2u*)(M + (size_t)row0 * M_LD + col0 + bj * 128); ngb[bj] = *(const v2u*)(M + (size_t)row0 * M_LD + 2048 + col0 + bj * 128);
            nga2[bj] = *(const v2u*)(M + (size_t)(row0 + 16) * M_LD + col0 + bj * 128); ngb2[bj] = *(const v2u*)(M + (size_t)(row0 + 16) * M_LD + 2048 + col0 + bj * 128); }
#pragma unroll
        for (int ai = 0; ai < 2; ++ai)
#pragma unroll
            for (int m = 0; m < 4; ++m) {
                v2u cga[2], cgb[2]; cga[0] = nga[0]; cga[1] = nga[1]; cgb[0] = ngb[0]; cgb[1] = ngb[1]; nga[0] = nga2[0]; nga[1] = nga2[1]; ngb[0] = ngb2[0]; ngb[1] = ngb2[1];
                if (ai * 4 + m < 6) { const int gn = ai * 4 + m + 2; const size_t rn = (size_t)(row0 + (gn >> 2) * 128 + (gn & 3) * 16);
#pragma unroll
                    for (int bj = 0; bj < 2; ++bj) { nga2[bj] = *(const v2u*)(M + rn * M_LD + col0 + bj * 128); ngb2[bj] = *(const v2u*)(M + rn * M_LD + 2048 + col0 + bj * 128); } }
#pragma unroll
                for (int bj = 0; bj < 2; ++bj) { const f32x4 a0 = unpack4_u8(cga[bj].x), a1 = unpack4_u8(cga[bj].y), b0 = unpack4_u8(cgb[bj].x), b1 = unpack4_u8(cgb[bj].y);
#pragma unroll
                    for (int j = 0; j < 4; ++j) { acc[ai][bj][m][0][j] *= keep * a0[j] * __builtin_amdgcn_rcpf(b0[j]); acc[ai][bj][m][1][j] *= keep * a1[j] * __builtin_amdgcn_rcpf(b1[j]); } }
                asm volatile("" : "+v"(acc[ai][0][m][0]), "+v"(acc[ai][0][m][1]), "+v"(acc[ai][1][m][0]), "+v"(acc[ai][1][m][1]));
                asm volatile("" ::: "memory"); }
    }
};

struct EpiRes {
    static constexpr bool PERM = true, ZERO_RESET = false;
    bf16* xb; float* rsp_out; LAS float* part;
    unsigned char* x8;
    __device__ __forceinline__ void operator()(const pg8::Acc& acc, const pg8::Unit& u, int wr, int wc, int fr, int fq) const {
        const int row0 = u.pm * 256 + wr * 64 + fr, col0 = u.pn * 256 + wc * 32 + 8 * fq;
        v4u nx[2], nx2[2];
#pragma unroll
        for (int bj = 0; bj < 2; ++bj) { nx[bj] = *(const v4u*)(xb + (size_t)row0 * D + col0 + bj * 128); nx2[bj] = *(const v4u*)(xb + (size_t)(row0 + 16) * D + col0 + bj * 128); }
#pragma unroll
        for (int ai = 0; ai < 2; ++ai)
#pragma unroll
            for (int m = 0; m < 4; ++m) { const size_t r = (size_t)(row0 + ai * 128 + m * 16); float ss = 0.f;
                v4u cx[2];
#pragma unroll
                for (int q = 0; q < 2; ++q) { cx[q] = nx[q]; nx[q] = nx2[q]; }
                if (ai * 4 + m < 6) { const int gn = ai * 4 + m + 2; const size_t rn = (size_t)(row0 + (gn >> 2) * 128 + (gn & 3) * 16);
#pragma unroll
                    for (int bj = 0; bj < 2; ++bj) nx2[bj] = *(const v4u*)(xb + rn * D + col0 + bj * 128); }
#pragma unroll
                for (int bj = 0; bj < 2; ++bj) { const size_t o = r * D + col0 + bj * 128; const v4u c = cx[bj];
                    const f32x4 x0 = (f32x4){bflo(c.x), bfhi(c.x), bflo(c.y), bfhi(c.y)} + acc[ai][bj][m][0], x1 = (f32x4){bflo(c.z), bfhi(c.z), bflo(c.w), bfhi(c.w)} + acc[ai][bj][m][1];
                    *(v4u*)(xb + o) = pack8(x0, x1);
                    if (x8) { v2u w; w.x = pack4_fp8(x0[0] * X8_SCALE, x0[1] * X8_SCALE, x0[2] * X8_SCALE, x0[3] * X8_SCALE); w.y = pack4_fp8(x1[0] * X8_SCALE, x1[1] * X8_SCALE, x1[2] * X8_SCALE, x1[3] * X8_SCALE); *(v2u*)(x8 + o) = w; }
                    ss += (x0[0] * x0[0] + x0[1] * x0[1]) + (x0[2] * x0[2] + x0[3] * x0[3]) + (x1[0] * x1[0] + x1[1] * x1[1]) + (x1[2] * x1[2] + x1[3] * x1[3]); }
                ss += __shfl_xor(ss, 16); ss += __shfl_xor(ss, 32);
                if (fq == 0) part[(wr * 64 + fr + ai * 128 + m * 16) * 4 + wc] = ss;
                asm volatile("" ::: "memory"); }
        asm volatile("s_waitcnt lgkmcnt(0)" ::: "memory"); __builtin_amdgcn_s_barrier(); asm volatile("" ::: "memory");
        const int t = (wr * 4 + wc) * 64 + fq * 16 + fr;
        if (t < 256) { const f32x4 p = *(const LAS f32x4*)(part + t * 4); rsp_out[(size_t)(u.pm * 256 + t) * 8 + u.pn] = (p[0] + p[1]) + (p[2] + p[3]); }
    }
    __device__ __forceinline__ void reset(pg8::Acc& acc, const pg8::Unit&, int, int, int, int) const { acc_zero(acc); }
};

struct EpiGU {
    static constexpr bool PERM = true, ZERO_RESET = false;
    const float* rsq; bf16* H; int ldh; LAS const float* rst;
    __device__ __forceinline__ void operator()(const pg8::Acc& acc, const pg8::Unit& u, int wr, int wc, int fr, int fq) const {
        const int row0 = u.pm * 256 + wr * 64 + fr, col0 = u.pn * 128 + wc * 32 + 8 * fq;
        RowScales RS; row_scales8_lds(RS, rst, u, row0);
#pragma unroll
        for (int ai = 0; ai < 2; ++ai)
#pragma unroll
            for (int m = 0; m < 4; ++m) { const size_t r = (size_t)(row0 + ai * 128 + m * 16); const float rs = RS.v[ai * 4 + m], nr = rs * NLOG2E, r2 = rs * rs;
                const f32x4 t0 = acc[ai][0][m][0] * nr, t1 = acc[ai][0][m][1] * nr;
                f32x4 h0 = acc[ai][0][m][0] * acc[ai][1][m][0] * r2, h1 = acc[ai][0][m][1] * acc[ai][1][m][1] * r2;
#pragma unroll
                for (int j = 0; j < 4; ++j) { h0[j] *= sig_pre(t0[j]); h1[j] *= sig_pre(t1[j]); }
                *(v4u*)(H + r * ldh + col0) = pack8(h0, h1); }
    }
    __device__ __forceinline__ void reset(pg8::Acc& acc, const pg8::Unit&, int, int, int, int) const { acc_zero(acc); }
};
struct EpiGUMoe {
    static constexpr bool PERM = true, ZERO_RESET = true;
    unsigned char* ACT8; MoeTiles mt;
    __device__ __forceinline__ void operator()(const pg8::Acc& acc, const pg8::Unit& u, int wr, int wc, int fr, int fq) const {
        const int e = u.aux & 255, lt = u.aux >> 8, n = mt.cnt_of(e);
        const int rl0 = wr * 64 + fr, col0 = u.pn * 128 + wc * 32 + 8 * fq;
#pragma unroll
        for (int ai = 0; ai < 2; ++ai)
#pragma unroll
            for (int m = 0; m < 4; ++m) { const int rl = rl0 + ai * 128 + m * 16, pos = lt * 256 + rl; const float sg = (1.0f / W8_SCALE), su = pos < n ? (ACT8_SCALE / W8_SCALE) * sg : 0.f;
                const f32x4 t0 = acc[ai][0][m][0] * (NLOG2E * sg), t1 = acc[ai][0][m][1] * (NLOG2E * sg);
                f32x4 h0 = acc[ai][0][m][0] * acc[ai][1][m][0] * su, h1 = acc[ai][0][m][1] * acc[ai][1][m][1] * su;
#pragma unroll
                for (int j = 0; j < 4; ++j) { h0[j] *= sig_pre(t0[j]); h1[j] *= sig_pre(t1[j]); }
                v2u w; w.x = pack4_fp8(h0[0], h0[1], h0[2], h0[3]); w.y = pack4_fp8(h1[0], h1[1], h1[2], h1[3]);
                *(v2u*)(ACT8 + (size_t)(u.pm * 256 + rl) * DFFE + col0) = w; }
    }
    __device__ __forceinline__ void reset(pg8::Acc& acc, const pg8::Unit&, int, int, int, int) const { acc_zero(acc); }
};
struct EpiDnMoe {
    static constexpr bool PERM = true, ZERO_RESET = true;
    bf16* YP;
    __device__ __forceinline__ void operator()(const pg8::Acc& acc, const pg8::Unit& u, int wr, int wc, int fr, int fq) const {
        const int row0 = u.pm * 256 + wr * 64 + fr, col0 = u.pn * 256 + wc * 32 + 8 * fq; bf16* yp = YP + (size_t)(u.aux >> 8) * ((size_t)MOE_MAXT * 256 * D);
        const float sc = 1.0f / (W8_SCALE * ACT8_SCALE);
#pragma unroll
        for (int ai = 0; ai < 2; ++ai)
#pragma unroll
            for (int m = 0; m < 4; ++m) { const size_t r = (size_t)(row0 + ai * 128 + m * 16);
#pragma unroll
                for (int bj = 0; bj < 2; ++bj) *(v4u*)(yp + r * D + col0 + bj * 128) = pack8(acc[ai][bj][m][0] * sc, acc[ai][bj][m][1] * sc); }
    }
    __device__ __forceinline__ void reset(pg8::Acc& acc, const pg8::Unit&, int, int, int, int) const { acc_zero(acc); }
};
constexpr size_t MiB = 1u << 20;
constexpr size_t WS_CTL = 0, CTL_ZERO_BYTES = 1 * MiB;
constexpr size_t WS_SMALL = 1 * MiB;
constexpr size_t WS_LBV = WS_SMALL;
constexpr size_t WS_LIST = WS_SMALL + 64 * 1024;
constexpr size_t WS_RSL = WS_LIST + 256 * 1024;
constexpr size_t WS_TSLOT = WS_RSL + 256 * 1024;
constexpr size_t WS_TW = WS_TSLOT + 64 * 1024;
constexpr size_t WS_DEC = 2 * MiB;
constexpr size_t WS_ER = 3 * MiB;
constexpr size_t WS_RSP = 4 * MiB;
constexpr size_t WS_WIN = 8 * MiB;
constexpr size_t WS_WPA = WS_WIN + 92 * MiB;
constexpr size_t WS_WPB = WS_WPA + 8 * MiB;
constexpr size_t WS_WOUT = WS_WPB + 8 * MiB;
constexpr size_t WS_WGU0 = WS_WOUT + 16 * MiB;
constexpr size_t WS_WD0 = WS_WGU0 + 44 * MiB;
constexpr size_t WS_WGUE = WS_WD0 + 22 * MiB;
constexpr size_t WS_WDE = WS_WGUE + 224 * MiB;
constexpr size_t WS_WIN8 = WS_WDE + 112 * MiB;
constexpr size_t WS_XB8 = WS_WIN8 + 16 * MiB;
constexpr size_t WS_XA = WS_XB8 + 16 * MiB;
constexpr size_t WS_XB = WS_XA + 64 * MiB;
constexpr size_t WS_MIX = WS_XB + 32 * MiB;
constexpr size_t WS_Q = WS_MIX;
constexpr size_t WS_K = WS_Q + 24 * MiB;
constexpr size_t WS_G = WS_K + 24 * MiB;
constexpr size_t WS_V = WS_G + 48 * MiB;
constexpr size_t WS_SG = WS_V + 32 * MiB;
constexpr size_t WS_M = WS_SG + 32 * MiB;
constexpr size_t WS_Y = WS_M + 64 * MiB;
constexpr size_t WS_MG = WS_Y + 32 * MiB;
constexpr size_t WS_LS = WS_MG + 32 * MiB;
constexpr size_t WS_SP = WS_LS + 128 * MiB;
constexpr size_t WS_MIX_END = WS_SP + 64 * MiB;
constexpr size_t WS_H = WS_MIX;
constexpr size_t WS_ACT = WS_MIX;
constexpr size_t WS_X8 = WS_ACT + 128 * MiB;
constexpr size_t WS_YP = WS_X8 + 16 * MiB;
static_assert(WS_YP + 144 * MiB <= WS_MIX_END, "MoE overlay fits the mixer region");
constexpr size_t WS_END = WS_MIX_END;
constexpr int CW_BAR = 4096;
constexpr int CW_CNT = 16384;

constexpr int RING_OFF = 0, RING_BYTES = 131072;
constexpr int LDSCTL_OFF = RING_BYTES, MISC_OFF = LDSCTL_OFF + 320;
constexpr int PART_OFF = RING_BYTES + 1024;
constexpr int LDS_BYTES = 147456;
constexpr int NWAVES = 8;

#define XB_TMO      128
#define XB_XCNT(j)  (256  + 64 * (j))
#define XB_XSUB(j)  (1280 + 64 * (j))
#define XB_XGEN(j)  (2304 + 64 * (j))
#define XB_TOP      3328
#define XB_TOPGEN   3392
#define XCD_BAR_WORDS 3456
#define XB_SPIN_CAP (1u << 18)

__device__ __forceinline__ unsigned xb_ld(unsigned* p)              { return __hip_atomic_load(p, __ATOMIC_RELAXED, __HIP_MEMORY_SCOPE_AGENT); }
__device__ __forceinline__ unsigned xb_add(unsigned* p, unsigned v) { return __hip_atomic_fetch_add(p, v, __ATOMIC_RELAXED, __HIP_MEMORY_SCOPE_AGENT); }
__device__ __forceinline__ unsigned xb_xcc_id() { return (unsigned)__builtin_amdgcn_s_getreg((3 << 11) | 20) & 0xFu; }
#define XB_SPIN(cond, bar) do { unsigned _sp = 0; while (cond) { __builtin_amdgcn_s_sleep(1); \
    if ((++_sp & 255u) == 0u) { if (xb_ld(&(bar)[XB_TMO])) break; if (_sp > XB_SPIN_CAP) { atomicAdd(&(bar)[XB_TMO], 1u); break; } } } } while (0)

struct XcdBarrier {
    unsigned* bar; unsigned x;
    volatile LAS unsigned* st;
};
__device__ __forceinline__ XcdBarrier xcd_barrier_post(unsigned* bar, volatile LAS unsigned* st) {
    XcdBarrier b; b.bar = bar; b.x = xb_xcc_id(); b.st = st;
    if (threadIdx.x == 0) (void)xb_add(&bar[XB_XCNT(b.x)], 1u);
    return b;
}
__device__ __forceinline__ void xcd_barrier_complete(unsigned* bar, unsigned x, unsigned& nloc, unsigned& nx) {
    const unsigned G = gridDim.x * gridDim.y * gridDim.z;
    unsigned sum, cnt, mine, sp = 0u;
    for (;;) {
        sum = 0u; cnt = 0u; mine = 0u;
#pragma unroll
        for (unsigned j = 0; j < 16; ++j) { const unsigned c = xb_ld(&bar[XB_XCNT(j)]); sum += c; cnt += (c > 0u) ? 1u : 0u; mine = (j == x) ? c : mine; }
        if (sum == G) break;
        __builtin_amdgcn_s_sleep(1);
        if ((++sp & 255u) == 0u) { if (xb_ld(&bar[XB_TMO])) break; if (sp > XB_SPIN_CAP) { atomicAdd(&bar[XB_TMO], 1u); break; } }
    }
    nloc = mine > 0u ? mine : 1u; nx = cnt > 0u ? cnt : 1u;
}
__device__ __forceinline__ void xcd_barrier(const XcdBarrier& b) {
    asm volatile("s_waitcnt vmcnt(0)" ::: "memory");
    __syncthreads();
    if (threadIdx.x == 0) {
        unsigned* bar = b.bar; asm volatile("" : "+s"(bar));
        __builtin_amdgcn_s_waitcnt(0);
        unsigned nloc = b.st[0], nx = b.st[1];
        if (nloc == 0u) { xcd_barrier_complete(bar, b.x, nloc, nx); b.st[0] = nloc; b.st[1] = nx; }
        const unsigned old = xb_add(&bar[XB_XSUB(b.x)], 1u);
        const unsigned gen = old / nloc;
        if (old + 1u == (gen + 1u) * nloc) {
            __builtin_amdgcn_fence(__ATOMIC_RELEASE, "agent");
            asm volatile("s_waitcnt vmcnt(0)" ::: "memory");
            const unsigned og = xb_add(&bar[XB_TOP], 1u);
            const unsigned tg = og / nx;
            if (og + 1u == (tg + 1u) * nx) xb_add(&bar[XB_TOPGEN], 1u);
            else XB_SPIN(xb_ld(&bar[XB_TOPGEN]) == tg, bar);
            __builtin_amdgcn_fence(__ATOMIC_ACQUIRE, "agent");
            xb_add(&bar[XB_XGEN(b.x)], 1u);
            asm volatile("s_waitcnt vmcnt(0)" ::: "memory");
        } else {
            XB_SPIN(xb_ld(&bar[XB_XGEN(b.x)]) == gen, bar);
            __builtin_amdgcn_fence(__ATOMIC_ACQUIRE, "agent");
            asm volatile("s_waitcnt vmcnt(0)" ::: "memory");
        }
    }
    __syncthreads();
}

struct ConvRegs { f32x4 w[8]; };
__device__ __forceinline__ void conv_load(ConvRegs& r, const float* W, int ldw, int c0, const float* kscale, int kb, int lane) {
    const int n4 = lane & 7, kg = lane >> 3; const float* src = W + (size_t)(64 * kb + 8 * kg) * ldw + c0 + 4 * n4;
#pragma unroll
    for (int i = 0; i < 8; ++i) r.w[i] = __builtin_nontemporal_load((const f32x4*)(src + (size_t)i * ldw));
    if (kscale) { const f32x4 s0 = *(const f32x4*)(kscale + 64 * kb + 8 * kg), s1 = *(const f32x4*)(kscale + 64 * kb + 8 * kg + 4);
#pragma unroll
        for (int i = 0; i < 4; ++i) { r.w[i] *= s0[i]; r.w[4 + i] *= s1[i]; } }
}
__device__ __forceinline__ void conv_store(const ConvRegs& r, int K, bf16* WT, int drow0, int kb, int lane) {
    const int n4 = lane & 7, kg = lane >> 3; bf16* dst = WT + (size_t)(drow0 + 4 * n4) * K + 64 * kb + 8 * kg;
#pragma unroll
    for (int j = 0; j < 4; ++j) { v4u o; o.x = cvt_pk_bf16(r.w[0][j], r.w[1][j]); o.y = cvt_pk_bf16(r.w[2][j], r.w[3][j]); o.z = cvt_pk_bf16(r.w[4][j], r.w[5][j]); o.w = cvt_pk_bf16(r.w[6][j], r.w[7][j]);
        *(v4u*)(dst + (size_t)j * K) = o; }
}
struct ConvJob { const float* W; const float* kscale; bf16* WT; int ldw, K, c0, drow0, kb; };
__device__ __forceinline__ unsigned pk4f8(float a, float b, float c, float d) { int w = 0; w = __builtin_amdgcn_cvt_pk_fp8_f32(a, b, w, false); w = __builtin_amdgcn_cvt_pk_fp8_f32(c, d, w, true); return (unsigned)w; }
__device__ __forceinline__ int gu_row(int c0, int isup) { return 256 * (c0 >> 7) + 128 * isup + (c0 & 127); }
struct Conv8Regs { f32x4 w[16]; };
__device__ __forceinline__ void conv8_load(Conv8Regs& r, const float* W, int ldw, int c0, int kb, int lane) {
    const int n4 = lane & 7, kg = lane >> 3; const float* src = W + (size_t)(128 * kb + 16 * kg) * ldw + c0 + 4 * n4;
#pragma unroll
    for (int i = 0; i < 16; ++i) r.w[i] = __builtin_nontemporal_load((const f32x4*)(src + (size_t)i * ldw));
}
__device__ __forceinline__ void conv8_store(const Conv8Regs& r, int K, const float* kscale, unsigned char* WT, int drow0, int kb, int lane) {
    const int n4 = lane & 7, kg = lane >> 3;
    float sc[16];
#pragma unroll
    for (int q = 0; q < 4; ++q) { f32x4 s4 = (f32x4){64.f, 64.f, 64.f, 64.f}; if (kscale) s4 = *(const f32x4*)(kscale + 128 * kb + 16 * kg + 4 * q) * 64.f; sc[4 * q] = s4[0]; sc[4 * q + 1] = s4[1]; sc[4 * q + 2] = s4[2]; sc[4 * q + 3] = s4[3]; }
    unsigned char* dst = WT + (size_t)(drow0 + 4 * n4) * K + 128 * kb + 16 * kg;
#pragma unroll
    for (int j = 0; j < 4; ++j) { v4u o;
        o.x = pk4f8(r.w[0][j] * sc[0], r.w[1][j] * sc[1], r.w[2][j] * sc[2], r.w[3][j] * sc[3]); o.y = pk4f8(r.w[4][j] * sc[4], r.w[5][j] * sc[5], r.w[6][j] * sc[6], r.w[7][j] * sc[7]);
        o.z = pk4f8(r.w[8][j] * sc[8], r.w[9][j] * sc[9], r.w[10][j] * sc[10], r.w[11][j] * sc[11]); o.w = pk4f8(r.w[12][j] * sc[12], r.w[13][j] * sc[13], r.w[14][j] * sc[14], r.w[15][j] * sc[15]);
        *(v4u*)(dst + (size_t)j * K) = o; }
}
struct Conv8Job { const float* W; const float* kscale; unsigned char* WT; int ldw, K, c0, drow0, kb; };
constexpr int I8_MG = 16 * 224, I8_MU = I8_MG, I8_MD = 56 * 64, I8_EXP = I8_MG + I8_MU + I8_MD, I8_ALL = NE * I8_EXP;
constexpr int I8_WIN = 2 * 16 * 128, I8_TOT = I8_ALL + I8_WIN;
struct Conv8Src { const float *wg, *wu, *wd, *fw, *win, *mw; };
__device__ __forceinline__ void conv8_decode(int it, const Conv8Src& c, unsigned char* ws, Conv8Job& j) {
    const float* wg = c.wg; const float* wu = c.wu; const float* wd = c.wd; const float* fw = c.fw;
    if (it >= I8_ALL) { const int r = it - I8_ALL, l = r >> 11, rr = r & 2047; j.kb = rr >> 7; const int nb = rr & 127;
        j.W = c.win + (size_t)l * D * DIN_SRC; j.ldw = DIN_SRC; j.K = D; j.c0 = 7184 + 32 * nb; j.kscale = c.mw + l * D; j.WT = ws + WS_WIN8 + (size_t)l * 4096 * D; j.drow0 = 32 * nb; return; }
    const int e = it / I8_EXP; int r = it - e * I8_EXP; unsigned char* wgu = ws + WS_WGUE + (size_t)e * 2 * DFFE * D;
    if (r < I8_MG) { j.kb = r / 224; const int nb = r % 224; j.W = wg + (size_t)e * D * DFFE; j.ldw = DFFE; j.K = D; j.c0 = 32 * nb; j.kscale = fw; j.WT = wgu; j.drow0 = gu_row(32 * nb, 0); return; } r -= I8_MG;
    if (r < I8_MU) { j.kb = r / 224; const int nb = r % 224; j.W = wu + (size_t)e * D * DFFE; j.ldw = DFFE; j.K = D; j.c0 = 32 * nb; j.kscale = fw; j.WT = wgu; j.drow0 = gu_row(32 * nb, 1); return; } r -= I8_MU;
    { j.kb = r / 64; const int nb = r % 64; j.W = wd + (size_t)e * DFFE * D; j.ldw = D; j.K = DFFE; j.c0 = 32 * nb; j.kscale = nullptr; j.WT = ws + WS_WDE + (size_t)e * D * DFFE; j.drow0 = 32 * nb; return; }
}
__device__ __forceinline__ void conv8_range(int lo, int hi, int w, int nw, const Conv8Src& c, unsigned char* ws, int lane) {
    Conv8Job j0, j1; Conv8Regs r0, r1; int i0 = lo + w, i1 = lo + w + nw;
    if (i0 < hi) { conv8_decode(i0, c, ws, j0); conv8_load(r0, j0.W, j0.ldw, j0.c0, j0.kb, lane); }
    if (i1 < hi) { conv8_decode(i1, c, ws, j1); conv8_load(r1, j1.W, j1.ldw, j1.c0, j1.kb, lane); }
    while (i0 < hi) {
        conv8_store(r0, j0.K, j0.kscale, j0.WT, j0.drow0, j0.kb, lane);
        i0 += 2 * nw; if (i0 < hi) { conv8_decode(i0, c, ws, j0); conv8_load(r0, j0.W, j0.ldw, j0.c0, j0.kb, lane); }
        if (i1 < hi) { conv8_store(r1, j1.K, j1.kscale, j1.WT, j1.drow0, j1.kb, lane);
            i1 += 2 * nw; if (i1 < hi) { conv8_decode(i1, c, ws, j1); conv8_load(r1, j1.W, j1.ldw, j1.c0, j1.kb, lane); } }
    }
}
struct P0Args {
    const float *x, *mix_norm_w, *w_in, *lbl, *gk_up_w, *w_proj_a, *w_proj_b, *w_out, *ffn_norm_w, *dense_w_gate, *dense_w_up, *dense_w_down, *moe_w_gate, *moe_w_up, *moe_w_down;
    unsigned char* ws;
};
__device__ __forceinline__ void p0_prologue(const P0Args& a, LAS unsigned char* lds, int vcu, int G, int wave, int lane) {
    const int gw = vcu * NWAVES + wave, NGW = G * NWAVES;
    unsigned char* ws = a.ws;
    constexpr int I_INA = 32 * 224, I_PA = 16 * 64, I_PB = 16 * 64, I_WO = 32 * 64;
    constexpr int I_LAYER = I_INA + I_PA + I_PB + I_WO;
    constexpr int I_DG = 32 * 176, I_DU = I_DG, I_DD = 88 * 64;
    constexpr int NITEMS = 2 * I_LAYER + I_DG + I_DU + I_DD;
    auto decode = [&](int it, ConvJob& j) {
        int r = it; j.kscale = nullptr;
        if (r < 2 * I_LAYER) {
            const int l = r / I_LAYER; r -= l * I_LAYER;
            const float* win = a.w_in + (size_t)l * D * DIN_SRC; bf16* wint = (bf16*)(ws + WS_WIN) + (size_t)l * NIN * D; const float* mw = a.mix_norm_w + l * D;
            if (r < I_INA) { j.kb = r / 224; const int nb = r % 224; j.W = win; j.ldw = DIN_SRC; j.K = D; j.c0 = 32 * nb; j.kscale = mw; j.WT = wint; j.drow0 = 32 * nb; return; } r -= I_INA;
            if (r < I_PA) { j.kb = r / 64; const int nb = r % 64; j.W = a.w_proj_a + (size_t)l * 1024 * D; j.ldw = D; j.K = 1024; j.c0 = 32 * nb; j.WT = (bf16*)(ws + WS_WPA) + (size_t)l * D * 1024; j.drow0 = 32 * nb; return; } r -= I_PA;
            if (r < I_PB) { j.kb = r / 64; const int nb = r % 64; j.W = a.w_proj_b + (size_t)l * 1024 * D; j.ldw = D; j.K = 1024; j.c0 = 32 * nb; j.WT = (bf16*)(ws + WS_WPB) + (size_t)l * D * 1024; j.drow0 = 32 * nb; return; } r -= I_PB;
            { j.kb = r / 64; const int nb = r % 64; j.W = a.w_out + (size_t)l * D * D; j.ldw = D; j.K = D; j.c0 = 32 * nb; j.WT = (bf16*)(ws + WS_WOUT) + (size_t)l * D * D; j.drow0 = 32 * nb; return; }
        }
        r -= 2 * I_LAYER;
        if (r < I_DG) { j.kb = r / 176; const int nb = r % 176; j.W = a.dense_w_gate; j.ldw = DFF; j.K = D; j.c0 = 32 * nb; j.kscale = a.ffn_norm_w; j.WT = (bf16*)(ws + WS_WGU0); j.drow0 = gu_row(32 * nb, 0); return; } r -= I_DG;
        if (r < I_DU) { j.kb = r / 176; const int nb = r % 176; j.W = a.dense_w_up; j.ldw = DFF; j.K = D; j.c0 = 32 * nb; j.kscale = a.ffn_norm_w; j.WT = (bf16*)(ws + WS_WGU0); j.drow0 = gu_row(32 * nb, 1); return; } r -= I_DU;
        { j.kb = r / 64; const int nb = r % 64; j.W = a.dense_w_down; j.ldw = D; j.K = DFF; j.c0 = 32 * nb; j.WT = (bf16*)(ws + WS_WD0); j.drow0 = 32 * nb; return; }
    };
    { ConvJob j[4]; ConvRegs r[4]; int ii[4];
#pragma unroll
      for (int q = 0; q < 4; ++q) { ii[q] = gw + q * NGW; if (ii[q] < NITEMS) { decode(ii[q], j[q]); conv_load(r[q], j[q].W, j[q].ldw, j[q].c0, j[q].kscale, j[q].kb, lane); } }
      while (ii[0] < NITEMS) {
#pragma unroll
          for (int q = 0; q < 4; ++q) { if (ii[q] < NITEMS) { conv_store(r[q], j[q].K, j[q].WT, j[q].drow0, j[q].kb, lane);
              ii[q] += 4 * NGW; if (ii[q] < NITEMS) { decode(ii[q], j[q]); conv_load(r[q], j[q].W, j[q].ldw, j[q].c0, j[q].kscale, j[q].kb, lane); } } }
      } }
    const int gt = (vcu * NWAVES + wave) * 64 + lane, NGT = NGW * 64;
    for (int idx = gt; idx < 2 * 512 * 256; idx += NGT) {
        const int l = idx / (512 * 256), rem = idx % (512 * 256), kq = rem / 512, j = rem % 512;
        const float* win = a.w_in + (size_t)l * D * DIN_SRC; const float* up = a.gk_up_w + (size_t)l * 16 * 512; const float* mw = a.mix_norm_w + l * D;
        float uj[16];
#pragma unroll
        for (int rr = 0; rr < 16; ++rr) uj[rr] = up[rr * 512 + j];
        float o[8];
#pragma unroll
        for (int kk = 0; kk < 8; ++kk) { const int k = 8 * kq + kk; const f32x4* wr = (const f32x4*)(win + (size_t)k * DIN_SRC + 7168); float s = 0.f;
#pragma unroll
            for (int q = 0; q < 4; ++q) { const f32x4 w = wr[q]; s += w[0] * uj[4 * q] + w[1] * uj[4 * q + 1] + w[2] * uj[4 * q + 2] + w[3] * uj[4 * q + 3]; }
            o[kk] = s * mw[k]; }
        v4u w; w.x = cvt_pk_bf16(o[0], o[1]); w.y = cvt_pk_bf16(o[2], o[3]); w.z = cvt_pk_bf16(o[4], o[5]); w.w = cvt_pk_bf16(o[6], o[7]);
        *(v4u*)((bf16*)(ws + WS_WIN) + (size_t)l * NIN * D + (size_t)(7168 + j) * D + 8 * kq) = w;
    }
    for (int idx = gt; idx < 2048; idx += NGT) { const int l = idx >> 10, c = idx & 1023; float v = 0.f;
        if (l == 1) { const float l0 = a.lbl[c], l1 = a.lbl[1024 + c]; v = 1.f / (1.f + __expf(l0 - l1)); }
        ((float*)(ws + WS_LBV))[idx] = v; }
    float* rsp0 = (float*)(ws + WS_RSP);
    for (int m = gw; m < T; m += NGW) {
        const f32x4* xr = (const f32x4*)(a.x + (size_t)m * D) + lane; f32x4 v[8]; float s = 0.f;
#pragma unroll
        for (int j = 0; j < 8; ++j) { v[j] = xr[64 * j]; s += (v[j][0] * v[j][0] + v[j][1] * v[j][1]) + (v[j][2] * v[j][2] + v[j][3] * v[j][3]); }
        s = wave_sum(s);
        v2u* o8 = (v2u*)((bf16*)(ws + WS_XB) + (size_t)m * D) + lane;
#pragma unroll
        for (int j = 0; j < 8; ++j) { v2u w; w.x = cvt_pk_bf16(v[j][0], v[j][1]); w.y = cvt_pk_bf16(v[j][2], v[j][3]); o8[64 * j] = w; }
        { unsigned* o4 = (unsigned*)(ws + WS_XB8 + (size_t)m * D) + lane;
#pragma unroll
          for (int j = 0; j < 8; ++j) o4[64 * j] = pack4_fp8(v[j][0] * X8_SCALE, v[j][1] * X8_SCALE, v[j][2] * X8_SCALE, v[j][3] * X8_SCALE); }
        if (lane == 0) { *(f32x4*)(rsp0 + (size_t)m * 8) = (f32x4){s, 0.f, 0.f, 0.f}; *(f32x4*)(rsp0 + (size_t)m * 8 + 4) = (f32x4){0.f, 0.f, 0.f, 0.f}; }
    }
}

typedef short v4i16_t __attribute__((ext_vector_type(4)));
__device__ __forceinline__ s16x4 tr_read(const LAS unsigned char* p) { return __builtin_bit_cast(s16x4, __builtin_amdgcn_ds_read_tr16_b64_v4i16((LAS v4i16_t*)p)); }
__device__ __forceinline__ bf16x8 tr_frag(const LAS unsigned char* img, int stride, int f0, int kk, int lane) {
    const int l16 = lane & 15, q = lane >> 4;
    const LAS unsigned char* p = img + (32 * kk + 8 * q + (l16 >> 2)) * stride + (f0 + 4 * (l16 & 3)) * 2;
    const s16x4 lo = tr_read(p), hi = tr_read(p + 4 * stride);
    bf16x8 r; r[0] = lo[0]; r[1] = lo[1]; r[2] = lo[2]; r[3] = lo[3]; r[4] = hi[0]; r[5] = hi[1]; r[6] = hi[2]; r[7] = hi[3]; return r;
}
__device__ __forceinline__ int head_ebase(int hh) { return hh < 8 ? hh * 16384 : 131072 + (hh - 8) * 32768; }
__device__ __forceinline__ int head_vcol(int hh) { return hh < 8 ? hh * 128 : 1024 + (hh - 8) * 256; }

struct LaPtrs { bf16 *Q, *Kb, *V, *SG, *Y, *SP, *LS; float *Gf, *DEC, *ER; const float *nwa, *nwb; };

struct ARegs { f32x4 g[4]; v2u q[4], k[4]; v4u v[4]; };
__device__ __forceinline__ void la_a_load(ARegs& R, const LaPtrs& P, int hh, int c, int tid) {
    const int dv = hh < 8 ? 128 : 256, qcol = hh * 128, vcol = head_vcol(hh), t0 = c * CH, dq = tid & 31, tg = tid >> 5, d0 = 4 * dq;
    const float* gp = P.Gf + (size_t)(t0 + 4 * tg) * QK_LD + qcol + d0;
#pragma unroll
    for (int s = 0; s < 4; ++s) { R.g[s] = *(const f32x4*)(gp + (size_t)s * QK_LD); const size_t idx = (size_t)(t0 + 4 * tg + s) * QK_LD + qcol + d0; R.q[s] = *(const v2u*)(P.Q + idx); R.k[s] = *(const v2u*)(P.Kb + idx); }
    const int cpr = dv / 8;
#pragma unroll
    for (int i = 0; i < 4; ++i) { if (i < dv / 64) { const int ch = tid + 512 * i, t = ch / cpr, cc = ch % cpr; R.v[i] = *(const v4u*)(P.V + (size_t)(t0 + t) * V_LD + vcol + cc * 8); } }
}
__device__ __forceinline__ void la_a_unit(const LaPtrs& P, LAS unsigned char* lds, int hh, int c, int tid, int wave, int lane, ARegs& R, bool has_next, int nhh, int nc) {
    const int dv = hh < 8 ? 128 : 256, qcol = hh * 128, t0 = c * CH;
    LAS float* tot = (LAS float*)lds;
    LAS float* elv = (LAS float*)(lds + 8192);
    LAS unsigned char* kimg = lds + 8192 + 512;
    LAS unsigned char* vimg = kimg + 64 * 288;
    const int vstride = (dv + 16) * 2;
    const int dq = tid & 31, tg = tid >> 5, d0 = 4 * dq;
    f32x4 cum[4];
    { f32x4 run = (f32x4){0.f, 0.f, 0.f, 0.f};
#pragma unroll
      for (int s = 0; s < 4; ++s) { run += R.g[s]; cum[s] = run; }
      *(LAS f32x4*)(tot + tg * 128 + d0) = run; }
    v2u qraw[4], kraw[4];
#pragma unroll
    for (int s = 0; s < 4; ++s) { qraw[s] = R.q[s]; kraw[s] = R.k[s]; }
    { const int cpr = dv / 8;
#pragma unroll
      for (int i = 0; i < 4; ++i) { if (i < dv / 64) { const int ch = tid + 512 * i, t = ch / cpr, cc = ch % cpr; *(LAS v4u*)(vimg + t * vstride + cc * 16) = R.v[i]; } } }
    if (has_next) la_a_load(R, P, nhh, nc, tid);
    __syncthreads();
    f32x4 off = (f32x4){0.f, 0.f, 0.f, 0.f}, cref = off, clast = off;
#pragma unroll
    for (int g = 0; g < 16; ++g) { const f32x4 tv = *(const LAS f32x4*)(tot + g * 128 + d0); if (g < tg) off += tv; if (g < 8) cref += tv; clast += tv; }
    if (tg == 0) { f32x4 e1, e2, e3;
#pragma unroll
        for (int j = 0; j < 4; ++j) { e1[j] = fast_exp(clast[j] - cref[j]); e2[j] = fast_exp(clast[j]); e3[j] = fast_exp(cref[j]); }
        *(LAS f32x4*)(elv + d0) = e1; *(f32x4*)(P.DEC + (size_t)(c * NHEADS + hh) * 128 + d0) = e2; *(f32x4*)(P.ER + (size_t)(c * NHEADS + hh) * 128 + d0) = e3; }
#pragma unroll
    for (int s = 0; s < 4; ++s) { const int t = 4 * tg + s; f32x4 eq, ek;
#pragma unroll
        for (int j = 0; j < 4; ++j) { const float x = clampf(cum[s][j] + off[j] - cref[j], -85.f, 85.f); eq[j] = fast_exp(x); ek[j] = fast_exp(-x); }
        v2u qo, ko; qo.x = cvt_pk_bf16(bflo(qraw[s].x) * eq[0], bfhi(qraw[s].x) * eq[1]); qo.y = cvt_pk_bf16(bflo(qraw[s].y) * eq[2], bfhi(qraw[s].y) * eq[3]);
        ko.x = cvt_pk_bf16(bflo(kraw[s].x) * ek[0], bfhi(kraw[s].x) * ek[1]); ko.y = cvt_pk_bf16(bflo(kraw[s].y) * ek[2], bfhi(kraw[s].y) * ek[3]);
        const size_t idx = (size_t)(t0 + t) * QK_LD + qcol + d0;
        *(v2u*)(P.Q + idx) = qo; *(v2u*)(P.Kb + idx) = ko; *(LAS v2u*)(kimg + t * 288 + d0 * 2) = ko; }
    __syncthreads();
    const int ntl = dv / 128;
    const int l16 = lane & 15, q4 = lane >> 4;
    bf16* LSc = P.LS + (size_t)c * STATE_E + head_ebase(hh);
    for (int ti = 0; ti < ntl; ++ti) {
        const int n0 = 16 * (wave * ntl + ti);
        const bf16x8 b0 = tr_frag(vimg, vstride, n0, 0, lane), b1 = tr_frag(vimg, vstride, n0, 1, lane);
#pragma unroll
        for (int dt = 0; dt < 8; ++dt) {
            const bf16x8 a0 = tr_frag(kimg, 288, 16 * dt, 0, lane), a1 = tr_frag(kimg, 288, 16 * dt, 1, lane);
            f32x4 acc = (f32x4){0.f, 0.f, 0.f, 0.f};
            acc = __builtin_amdgcn_mfma_f32_16x16x32_bf16(a0, b0, acc, 0, 0, 0);
            acc = __builtin_amdgcn_mfma_f32_16x16x32_bf16(a1, b1, acc, 0, 0, 0);
            const f32x4 el = *(const LAS f32x4*)(elv + 16 * dt + 4 * q4);
            { const f32x4 lv = acc * el; v2u w; w.x = cvt_pk_bf16(lv[0], lv[1]); w.y = cvt_pk_bf16(lv[2], lv[3]); *(v2u*)(LSc + (size_t)(n0 + l16) * 128 + 16 * dt + 4 * q4) = w; }
        }
    }
    __syncthreads();
}

__device__ __forceinline__ void la_b_scan(const LaPtrs& P, LAS unsigned char* lds, int bx, int G, int tid) {
    LAS float* decs = (LAS float*)lds; LAS float* ers = (LAS float*)(lds + 65536);
    for (int p0 = bx * 256; p0 < STATE_E / 4; p0 += G * 256) {
        const int e0 = 4 * p0; const int hh = e0 < 131072 ? (e0 >> 14) : 8 + ((e0 - 131072) >> 15);
        for (int i = tid; i < 4096; i += 512) { const int c = i >> 5, q = i & 31;
            *(LAS f32x4*)(decs + c * 128 + 4 * q) = *(const f32x4*)(P.DEC + (size_t)(c * NHEADS + hh) * 128 + 4 * q);
            *(LAS f32x4*)(ers + c * 128 + 4 * q) = *(const f32x4*)(P.ER + (size_t)(c * NHEADS + hh) * 128 + 4 * q); }
        __syncthreads();
        {
            const int e = e0 + 2 * tid, d = e & 127;
            f32x2_t s = (f32x2_t){0.f, 0.f};
            const bf16* lsp = P.LS + e; bf16* spp = P.SP + e;
            unsigned cur[32], nxt[32];
#pragma unroll
            for (int j = 0; j < 32; ++j) cur[j] = __builtin_nontemporal_load((const unsigned*)(lsp + (size_t)j * STATE_E));
            for (int c0 = 0; c0 < NCH; c0 += 32) {
                if (c0 + 32 < NCH) {
#pragma unroll
                    for (int j = 0; j < 32; ++j) nxt[j] = __builtin_nontemporal_load((const unsigned*)(lsp + (size_t)(c0 + 32 + j) * STATE_E)); }
#pragma unroll
                for (int j = 0; j < 32; ++j) { const int c = c0 + j;
                    const f32x2_t er = *(const LAS f32x2_t*)(ers + c * 128 + d), dc = *(const LAS f32x2_t*)(decs + c * 128 + d);
                    const f32x2_t l = (f32x2_t){bflo(cur[j]), bfhi(cur[j])};
                    const f32x2_t sp = er * s;
                    *(unsigned*)(spp + (size_t)c * STATE_E) = cvt_pk_bf16(sp[0], sp[1]);
                    s = dc * s + l; }
#pragma unroll
                for (int j = 0; j < 32; ++j) cur[j] = nxt[j];
            }
        }
        __syncthreads();
    }
}

struct CRegs { v4u q[2], k[2], v[4]; };
__device__ __forceinline__ void la_c_load(CRegs& R, const LaPtrs& P, int hh, int c, int tid) {
    const int dv = hh < 8 ? 128 : 256, qcol = hh * 128, vcol = head_vcol(hh), t0 = c * CH;
    { const int t = tid >> 3, cc = tid & 7; const bf16* qp = P.Q + (size_t)(t0 + t) * QK_LD + qcol + cc * 8; const bf16* kp = P.Kb + (size_t)(t0 + t) * QK_LD + qcol + cc * 8;
      R.q[0] = *(const v4u*)qp; R.q[1] = *(const v4u*)(qp + 64); R.k[0] = *(const v4u*)kp; R.k[1] = *(const v4u*)(kp + 64); }
    const int cpr = dv / 8;
#pragma unroll
    for (int i = 0; i < 4; ++i) { if (i < dv / 64) { const int ch = tid + 512 * i, t = ch / cpr, cc = ch % cpr; R.v[i] = *(const v4u*)(P.V + (size_t)(t0 + t) * V_LD + vcol + cc * 8); } }
}
__device__ __forceinline__ void la_c_unit(const LaPtrs& P, LAS unsigned char* lds, int hh, int c, int tid, int wave, int lane, CRegs& R, bool has_next, int nhh, int nc) {
    const int dv = hh < 8 ? 128 : 256, qcol = hh * 128, vcol = head_vcol(hh), t0 = c * CH;
    LAS unsigned char* As = lds;
    LAS float* red = (LAS float*)(lds + 9216);
    LAS unsigned char* qimg = lds + 12288;
    LAS unsigned char* kimg = qimg + 64 * 272;
    LAS unsigned char* vimg = kimg + 64 * 272;
    const int vstride = (dv + 16) * 2;
    const int l16 = lane & 15, q4 = lane >> 4;
    const int ntl = dv / 128;
    { const int t = tid >> 3, cc = tid & 7;
      *(LAS v4u*)(qimg + t * 272 + cc * 16) = R.q[0]; *(LAS v4u*)(qimg + t * 272 + 128 + cc * 16) = R.q[1]; *(LAS v4u*)(kimg + t * 272 + cc * 16) = R.k[0]; *(LAS v4u*)(kimg + t * 272 + 128 + cc * 16) = R.k[1]; }
    { const int cpr = dv / 8;
#pragma unroll
      for (int i = 0; i < 4; ++i) { if (i < dv / 64) { const int ch = tid + 512 * i, t = ch / cpr, cc = ch % cpr; *(LAS v4u*)(vimg + t * vstride + cc * 16) = R.v[i]; } } }
    const bf16* SPc = P.SP + (size_t)c * STATE_E + head_ebase(hh);
    bf16x8 as[2][4];
    v2u gt[2][4]; f32x4 nwv[2];
    const float* nw = hh < 8 ? P.nwa : P.nwb;
#pragma unroll
    for (int ti = 0; ti < 2; ++ti) { if (ti < ntl) { const int n0 = 16 * (wave * ntl + ti);
#pragma unroll
        for (int kk = 0; kk < 4; ++kk) as[ti][kk] = *(const bf16x8*)(SPc + (size_t)(n0 + l16) * 128 + 32 * kk + 8 * q4);
        nwv[ti] = *(const f32x4*)(nw + n0 + 4 * q4);
#pragma unroll
        for (int it = 0; it < 4; ++it) gt[ti][it] = *(const v2u*)(P.SG + (size_t)(t0 + 16 * it + l16) * V_LD + vcol + n0 + 4 * q4); } }
    if (has_next) la_c_load(R, P, nhh, nc, tid);
    __syncthreads();
    { const int jt = wave >> 1;
#pragma unroll
      for (int ii = 0; ii < 2; ++ii) { const int it = 2 * (wave & 1) + ii; const int j0 = 16 * jt, i0 = 16 * it;
          f32x4 acc = (f32x4){0.f, 0.f, 0.f, 0.f};
          if (jt <= it) {
#pragma unroll
              for (int kk = 0; kk < 4; ++kk) { const bf16x8 kf = *(const LAS bf16x8*)(kimg + (j0 + l16) * 272 + (32 * kk + 8 * q4) * 2), qf = *(const LAS bf16x8*)(qimg + (i0 + l16) * 272 + (32 * kk + 8 * q4) * 2);
                  acc = __builtin_amdgcn_mfma_f32_16x16x32_bf16(kf, qf, acc, 0, 0, 0); } }
          const int i = i0 + l16; f32x4 mv;
#pragma unroll
          for (int jj = 0; jj < 4; ++jj) mv[jj] = (j0 + 4 * q4 + jj <= i) ? acc[jj] : 0.f;
          v2u w; w.x = cvt_pk_bf16(mv[0], mv[1]); w.y = cvt_pk_bf16(mv[2], mv[3]);
          *(LAS v2u*)(As + i * 144 + (j0 + 4 * q4) * 2) = w; } }
    __syncthreads();
    f32x4 o[2][4];
#pragma unroll
    for (int ti = 0; ti < 2; ++ti)
#pragma unroll
        for (int it = 0; it < 4; ++it) o[ti][it] = (f32x4){0.f, 0.f, 0.f, 0.f};
#pragma unroll
    for (int it = 0; it < 4; ++it) { const int i0 = 16 * it;
        const bf16x8 bf0 = *(const LAS bf16x8*)(As + (i0 + l16) * 144 + (8 * q4) * 2), bf1 = *(const LAS bf16x8*)(As + (i0 + l16) * 144 + (32 + 8 * q4) * 2);
        bf16x8 bq[4];
#pragma unroll
        for (int kk = 0; kk < 4; ++kk) bq[kk] = *(const LAS bf16x8*)(qimg + (i0 + l16) * 272 + (32 * kk + 8 * q4) * 2);
#pragma unroll
        for (int ti = 0; ti < 2; ++ti) { if (ti < ntl) { const int n0 = 16 * (wave * ntl + ti);
            const bf16x8 av0 = tr_frag(vimg, vstride, n0, 0, lane), av1 = tr_frag(vimg, vstride, n0, 1, lane);
            f32x4 acc = (f32x4){0.f, 0.f, 0.f, 0.f};
            acc = __builtin_amdgcn_mfma_f32_16x16x32_bf16(av0, bf0, acc, 0, 0, 0);
            acc = __builtin_amdgcn_mfma_f32_16x16x32_bf16(av1, bf1, acc, 0, 0, 0);
#pragma unroll
            for (int kk = 0; kk < 4; ++kk) acc = __builtin_amdgcn_mfma_f32_16x16x32_bf16(as[ti][kk], bq[kk], acc, 0, 0, 0);
            o[ti][it] = acc; } } }
#pragma unroll
    for (int it = 0; it < 4; ++it) { float s = 0.f;
#pragma unroll
        for (int ti = 0; ti < 2; ++ti) s += (o[ti][it][0] * o[ti][it][0] + o[ti][it][1] * o[ti][it][1]) + (o[ti][it][2] * o[ti][it][2] + o[ti][it][3] * o[ti][it][3]);
        s += __shfl_xor(s, 16); s += __shfl_xor(s, 32);
        if (q4 == 0) red[(16 * it + l16) * 8 + wave] = s; }
    __syncthreads();
    const float inv_dv = 1.0f / (float)dv;
#pragma unroll
    for (int it = 0; it < 4; ++it) { const int i = 16 * it + l16;
        const f32x4 ra = *(const LAS f32x4*)(red + i * 8), rb = *(const LAS f32x4*)(red + i * 8 + 4);
        const float r = __builtin_amdgcn_rsqf(((ra[0] + ra[1]) + (ra[2] + ra[3]) + (rb[0] + rb[1]) + (rb[2] + rb[3])) * inv_dv + EPS);
#pragma unroll
        for (int ti = 0; ti < 2; ++ti) { if (ti < ntl) { const int n = 16 * (wave * ntl + ti) + 4 * q4; const size_t idx = (size_t)(t0 + i) * V_LD + vcol + n;
            const f32x4 w = nwv[ti]; const v2u g = gt[ti][it];
            v2u y; y.x = cvt_pk_bf16(o[ti][it][0] * r * w[0] * bflo(g.x), o[ti][it][1] * r * w[1] * bfhi(g.x)); y.y = cvt_pk_bf16(o[ti][it][2] * r * w[2] * bflo(g.y), o[ti][it][3] * r * w[3] * bfhi(g.y));
            *(v2u*)(P.Y + idx) = y; } } }
    __syncthreads();
}

struct MoePtrs { const bf16* XB; const float* router_w; const float* router_b; const float* fnw; unsigned* counts; int* list; unsigned char* X8; int* tslot; float* tw; };
__device__ __forceinline__ void moe_router(const MoePtrs& P, LAS unsigned char* lds, int gw, int NGW, int wave, int lane) {
    LAS unsigned* cntl = (LAS unsigned*)lds; LAS unsigned* basel = cntl + 8;
    LAS float* rw = (LAS float*)(lds + 256);
    const int tid = wave * 64 + lane;
    for (int i = tid; i < D * NE / 4; i += 512) { const int k = i >> 1, half = i & 1, L = (k >> 2) & 63, slot = (k >> 8) * 4 + (k & 3); const float g = P.fnw[k];
        *(LAS f32x4*)(rw + ((half * 32 + slot) * 64 + L) * 4) = *(const f32x4*)(P.router_w + 4 * i) * g; }
    constexpr int RK = 4;
    for (int tb0 = 0; tb0 < T; tb0 += RK * NGW) {
        if (tid < 8) cntl[tid] = 0u;
        __syncthreads();
        int e0s[RK], e1s[RK]; float w0s[RK]; unsigned r0s[RK], r1s[RK];
        v2u xall[RK][8];
#pragma unroll
        for (int kq = 0; kq < RK; ++kq) { const int t = tb0 + kq * NGW + gw; const v2u* xr = (const v2u*)(P.XB + (size_t)(t < T ? t : 0) * D) + lane;
#pragma unroll
            for (int j = 0; j < 8; ++j) xall[kq][j] = xr[64 * j]; }
#pragma unroll
        for (int kq = 0; kq < RK; ++kq) { const int t = tb0 + kq * NGW + gw; e0s[kq] = -1; e1s[kq] = -1; w0s[kq] = 0.f; r0s[kq] = 0u; r1s[kq] = 0u;
            if (t < T) {
                float ss = 0.f; float lg[NE]; f32x4 xv[8];
#pragma unroll
                for (int e = 0; e < NE; ++e) lg[e] = 0.f;
#pragma unroll
                for (int j = 0; j < 8; ++j) xv[j] = (f32x4){bflo(xall[kq][j].x), bfhi(xall[kq][j].x), bflo(xall[kq][j].y), bfhi(xall[kq][j].y)};
#pragma unroll
                for (int j = 0; j < 8; ++j) { const f32x4 x = xv[j]; ss += (x[0] * x[0] + x[1] * x[1]) + (x[2] * x[2] + x[3] * x[3]);
#pragma unroll
                    for (int i = 0; i < 4; ++i) { const float xw = x[i]; const f32x4 r0 = *(const LAS f32x4*)(rw + ((4 * j + i) * 64 + lane) * 4), r1 = *(const LAS f32x4*)(rw + ((32 + 4 * j + i) * 64 + lane) * 4);
                        lg[0] += xw * r0[0]; lg[1] += xw * r0[1]; lg[2] += xw * r0[2]; lg[3] += xw * r0[3]; lg[4] += xw * r1[0]; lg[5] += xw * r1[1]; lg[6] += xw * r1[2]; lg[7] += xw * r1[3]; } }
                ss = wave_sum(ss); const float rs = __builtin_amdgcn_rsqf(ss * (1.0f / D) + EPS);
                { unsigned* x8 = (unsigned*)(P.X8 + (size_t)t * D) + lane;
#pragma unroll
                  for (int j = 0; j < 8; ++j) x8[64 * j] = pk4f8(xv[j][0] * rs, xv[j][1] * rs, xv[j][2] * rs, xv[j][3] * rs); }
#pragma unroll
                for (int e = 0; e < NE; ++e) lg[e] = wave_sum(lg[e]) * rs + P.router_b[e];
                int e0 = 0; float l0 = lg[0];
#pragma unroll
                for (int e = 1; e < NE; ++e) if (lg[e] > l0) { l0 = lg[e]; e0 = e; }
                int e1 = -1; float l1 = -3.0e38f;
#pragma unroll
                for (int e = 0; e < NE; ++e) if (e != e0 && lg[e] > l1) { l1 = lg[e]; e1 = e; }
                e0s[kq] = e0; e1s[kq] = e1; w0s[kq] = 1.0f / (1.0f + __expf(l1 - l0));
                if (lane == 0) { r0s[kq] = __hip_atomic_fetch_add(cntl + e0, 1u, __ATOMIC_RELAXED, __HIP_MEMORY_SCOPE_WORKGROUP); r1s[kq] = __hip_atomic_fetch_add(cntl + e1, 1u, __ATOMIC_RELAXED, __HIP_MEMORY_SCOPE_WORKGROUP); }
            } }
        __syncthreads();
        if (tid < 8) basel[tid] = __hip_atomic_fetch_add(P.counts + tid, cntl[tid], RLX_AGENT);
        __syncthreads();
        if (lane == 0) {
#pragma unroll
            for (int kq = 0; kq < RK; ++kq) { const int t = tb0 + kq * NGW + gw; if (t < T) { const int e0 = e0s[kq], e1 = e1s[kq];
                const unsigned p0 = basel[e0] + r0s[kq], p1 = basel[e1] + r1s[kq];
                if (p0 < (unsigned)MOE_CAP) P.list[e0 * MOE_CAP + p0] = t;
                if (p1 < (unsigned)MOE_CAP) P.list[e1 * MOE_CAP + p1] = t;
                P.tslot[2 * t] = e0 * MOE_CAP + (int)p0; P.tslot[2 * t + 1] = e1 * MOE_CAP + (int)p1; P.tw[2 * t] = w0s[kq]; P.tw[2 * t + 1] = 1.0f - w0s[kq]; } } }
        __syncthreads();
    }
}
__device__ __forceinline__ void final_phase(const bf16* XB, const bf16* YP, const int* tslot, const float* tw, const MoeTiles& mt, const float* fw, float* out, int gw, int NGW, int lane) {
    for (int t = gw; t < T; t += NGW) {
        const int s0 = tslot[2 * t], s1 = tslot[2 * t + 1]; const float w0 = tw[2 * t], w1 = tw[2 * t + 1];
        const int e0 = s0 / MOE_CAP, p0 = s0 % MOE_CAP, e1 = s1 / MOE_CAP, p1 = s1 % MOE_CAP;
        const size_t r0 = (size_t)mt.tb_of(e0) * 256 + p0, r1 = (size_t)mt.tb_of(e1) * 256 + p1;
        const v2u* xr = (const v2u*)(XB + (size_t)t * D) + lane; const v2u* y0 = (const v2u*)(YP + r0 * D) + lane; const v2u* y1 = (const v2u*)(YP + r1 * D) + lane; const size_t hb = (size_t)MOE_MAXT * 256 * D / 4;
        f32x4 v[8]; float ss = 0.f;
#pragma unroll
        for (int j = 0; j < 8; ++j) { const v2u xw = xr[64 * j]; const f32x4 x = (f32x4){bflo(xw.x), bfhi(xw.x), bflo(xw.y), bfhi(xw.y)}; const v2u a = y0[64 * j], b = y1[64 * j], a2 = y0[hb + 64 * j], b2 = y1[hb + 64 * j];
            v[j][0] = x[0] + w0 * (bflo(a.x) + bflo(a2.x)) + w1 * (bflo(b.x) + bflo(b2.x)); v[j][1] = x[1] + w0 * (bfhi(a.x) + bfhi(a2.x)) + w1 * (bfhi(b.x) + bfhi(b2.x));
            v[j][2] = x[2] + w0 * (bflo(a.y) + bflo(a2.y)) + w1 * (bflo(b.y) + bflo(b2.y)); v[j][3] = x[3] + w0 * (bfhi(a.y) + bfhi(a2.y)) + w1 * (bfhi(b.y) + bfhi(b2.y));
            ss += (v[j][0] * v[j][0] + v[j][1] * v[j][1]) + (v[j][2] * v[j][2] + v[j][3] * v[j][3]); }
        ss = wave_sum(ss); const float rs = __builtin_amdgcn_rsqf(ss * (1.0f / D) + EPS);
        f32x4* orow = (f32x4*)(out + (size_t)t * D) + lane; const f32x4* fwv = (const f32x4*)fw + lane;
#pragma unroll
        for (int j = 0; j < 8; ++j) orow[64 * j] = v[j] * rs * fwv[64 * j];
    }
}
#ifndef PHASE_MASK
#define PHASE_MASK 0x1fff
#endif
#define PH_ON(k) (((PHASE_MASK) >> (k)) & 1)
#ifndef CONV_CUTS
#define CONV_CUTS 1000, 1000, 1000, 1000
#endif
#ifndef MK_SPLIT
#define MK_SPLIT 0
#endif
constexpr int N_PHASES = 20;
struct Args { const float* in[21]; float* out; unsigned char* ws; int ph_lo, ph_hi, flags, pad; };
static_assert(sizeof(Args) == 21 * 8 + 8 + 8 + 16, "Args has no padding");

__device__ __forceinline__ unsigned char* ws_of(const Args& a) { size_t z = 0; asm volatile("" : "+s"(z)); return a.ws + z; }
__device__ __forceinline__ const float* in_of(const Args& a, int i) { asm volatile("" : "+s"(i)); return a.in[i]; }

__global__ void __launch_bounds__(NWAVES * 64, 2) trunk_fwd(Args args) {
    extern __shared__ __attribute__((aligned(16))) unsigned char lds_raw[];
    LAS unsigned char* lds = (LAS unsigned char*)lds_raw;
    volatile LAS unsigned* MISC = (volatile LAS unsigned*)(lds + MISC_OFF);
    const int G = gridDim.x; const int bx = blockIdx.x; const int vcu = (G % 8 == 0) ? (bx % 8) * (G / 8) + bx / 8 : bx;
    for (int u = threadIdx.x; u < (LDS_BYTES - LDSCTL_OFF) / 4; u += NWAVES * 64) ((LAS unsigned*)(lds + LDSCTL_OFF))[u] = 0u;
    __syncthreads();
    XcdBarrier bar; bar.bar = (unsigned*)(args.ws + WS_CTL) + CW_BAR; bar.x = 0; bar.st = nullptr;
    if (!MK_SPLIT) bar = xcd_barrier_post((unsigned*)(args.ws + WS_CTL) + CW_BAR, MISC + 8);
    const int lo = args.ph_lo, hi = args.ph_hi;
#define IN(k) (lo <= (k) && (k) < hi)
#define SEAM(k) do { if (!MK_SPLIT && IN((k) + 1)) xcd_barrier(bar); } while (0)
    const int NGW = G * NWAVES;
#define NSPARE(nunits) (MK_SPLIT ? 0 : (G - (((nunits) + (((nunits) + G - 1) / G) - 1) / (((nunits) + G - 1) / G))))
#define CONV_SLICE(k, nc) do { } while (0)
#define PH_TID() int tz_ = threadIdx.x; asm volatile("" : "+v"(tz_)); const int tid = tz_, lane = tz_ & 63, wave = __builtin_amdgcn_readfirstlane(tz_ >> 6), gw = vcu * NWAVES + wave; (void)tid; (void)lane; (void)gw

    if (PH_ON(0) && IN(0)) {
        unsigned char* ws = ws_of(args); PH_TID();
        P0Args a; a.x = in_of(args, 0); a.mix_norm_w = in_of(args, 1); a.w_in = in_of(args, 2); a.lbl = in_of(args, 3); a.gk_up_w = in_of(args, 4); a.w_proj_a = in_of(args, 8); a.w_proj_b = in_of(args, 9); a.w_out = in_of(args, 10);
        a.ffn_norm_w = in_of(args, 11); a.dense_w_gate = in_of(args, 12); a.dense_w_up = in_of(args, 13); a.dense_w_down = in_of(args, 14); a.moe_w_gate = in_of(args, 17); a.moe_w_up = in_of(args, 18); a.moe_w_down = in_of(args, 19); a.ws = ws;
        { Conv8Src c8; c8.wg = a.moe_w_gate; c8.wu = a.moe_w_up; c8.wd = a.moe_w_down; c8.fw = a.ffn_norm_w + D; c8.win = a.w_in; c8.mw = a.mix_norm_w;
          conv8_range(0, I8_TOT, vcu * NWAVES + wave, G * NWAVES, c8, ws, lane); }
        p0_prologue(a, lds, vcu, G, wave, lane);
        SEAM(0);
    }
    for (int layer = 0; layer < DEPTH; ++layer) {
        const int pb = 1 + 9 * layer;
#define LP_SETUP() LaPtrs LP; LP.Q = (bf16*)(ws + WS_Q); LP.Kb = (bf16*)(ws + WS_K); LP.V = (bf16*)(ws + WS_V); LP.SG = (bf16*)(ws + WS_SG); LP.Y = (bf16*)(ws + WS_Y); LP.SP = (bf16*)(ws + WS_SP); \
        LP.Gf = (float*)(ws + WS_G); LP.LS = (bf16*)(ws + WS_LS); LP.DEC = (float*)(ws + WS_DEC); LP.ER = (float*)(ws + WS_ER); LP.nwa = nullptr; LP.nwb = nullptr;
        if (PH_ON(1) && IN(pb + 0)) {
            unsigned char* ws = ws_of(args); PH_TID();
            { SchedDense8 S; S.A = (const char*)(ws + WS_XB8); S.Bt = (const char*)(ws + WS_WIN8 + (size_t)layer * 4096 * D); S.nM = T / 256; S.nN = 16; S.G = G; S.c = bx; S.skip_epi = args.flags & 1; S.shape(D, D);
              EpiIn8 E; E.rsq = (const float*)(ws + WS_RSP) + (size_t)(2 * layer) * T * 8; E.M = ws + WS_M; E.rst = (LAS const float*)(lds + RST_OFF);
              stage_row_scales(lds, S, E.rsq, tid);
              pg8::gemm_phase<EpiIn8, SchedDense8, true>(lds + RING_OFF, S, E); }
            __syncthreads();
            { const int nc = NSPARE((T / 256) * NIN_BF);
              SchedDense S; S.A = (const char*)(ws + WS_XB); S.Bt = (const char*)((bf16*)(ws + WS_WIN) + (size_t)layer * NIN * D); S.nM = bx < nc ? 0 : T / 256; S.nN = NIN_BF; S.G = G - nc; S.c = bx < nc ? 0 : bx - nc; S.skip_epi = args.flags & 1; S.shape(D, D);
              EpiIn E; E.rsq = (const float*)(ws + WS_RSP) + (size_t)(2 * layer) * T * 8; E.Q = (bf16*)(ws + WS_Q); E.Kb = (bf16*)(ws + WS_K); E.V = (bf16*)(ws + WS_V); E.SG = (bf16*)(ws + WS_SG); E.M = (bf16*)(ws + WS_M); E.Gf = (float*)(ws + WS_G);
              E.lbv = (const float*)(ws + WS_LBV) + layer * 1024; E.gkb = in_of(args, 5) + layer * 512; E.rst = (LAS const float*)(lds + RST_OFF);
              stage_row_scales(lds, S, E.rsq, tid);
              pg8::gemm_phase<EpiIn, SchedDense, true>(lds + RING_OFF, S, E); }
            SEAM(pb + 0);
        }
        if (PH_ON(2) && IN(pb + 1)) {
            unsigned char* ws = ws_of(args); PH_TID(); LP_SETUP();
            { ARegs R; la_a_load(R, LP, (bx % (NHEADS * NCH)) % NHEADS, (bx % (NHEADS * NCH)) / NHEADS, tid);
              for (int u = bx; u < NHEADS * NCH; u += G) { const int un = u + G; la_a_unit(LP, lds, u % NHEADS, u / NHEADS, tid, wave, lane, R, un < NHEADS * NCH, un % NHEADS, un / NHEADS); } }
            SEAM(pb + 1);
        }
        if (PH_ON(3) && IN(pb + 2)) {
            unsigned char* ws = ws_of(args); PH_TID(); LP_SETUP();
            la_b_scan(LP, lds, bx, G, tid);
            SEAM(pb + 2);
        }
        if (PH_ON(4) && IN(pb + 3)) {
            unsigned char* ws = ws_of(args); PH_TID(); LP_SETUP(); LP.nwa = in_of(args, 6) + layer * 128; LP.nwb = in_of(args, 7) + layer * 256;
            { CRegs R; la_c_load(R, LP, (bx % (NHEADS * NCH)) % NHEADS, (bx % (NHEADS * NCH)) / NHEADS, tid);
              for (int u = bx; u < NHEADS * NCH; u += G) { const int un = u + G; la_c_unit(LP, lds, u % NHEADS, u / NHEADS, tid, wave, lane, R, un < NHEADS * NCH, un % NHEADS, un / NHEADS); } }
            SEAM(pb + 3);
        }
        if (PH_ON(5) && IN(pb + 4)) {
            unsigned char* ws = ws_of(args); PH_TID();
            SchedProj S; S.Y = (const char*)(ws + WS_Y); S.Wa = (const char*)((bf16*)(ws + WS_WPA) + (size_t)layer * D * 1024); S.Wb = (const char*)((bf16*)(ws + WS_WPB) + (size_t)layer * D * 1024); S.G = G; S.c = bx; S.skip_epi = args.flags & 1; S.ldaB = D * 2; S.ldbB = 1024 * 2; S.KB = 1024 * 2;
            EpiProj E; E.M = ws + WS_M; E.MG = (bf16*)(ws + WS_MG);
            pg8::gemm_phase<EpiProj, SchedProj, false>(lds + RING_OFF, S, E);
            SEAM(pb + 4);
        }
        if (PH_ON(6) && IN(pb + 5)) {
            unsigned char* ws = ws_of(args); PH_TID();
            SchedDense S; S.A = (const char*)(ws + WS_MG); S.Bt = (const char*)((bf16*)(ws + WS_WOUT) + (size_t)layer * D * D); S.nM = T / 256; S.nN = D / 256; S.G = G; S.c = bx; S.skip_epi = args.flags & 1; S.shape(D, D);
            EpiRes E; E.xb = (bf16*)(ws + WS_XB); E.rsp_out = (float*)(ws + WS_RSP) + (size_t)(layer == 0 ? 1 : 2) * T * 8; E.part = (LAS float*)(lds + PART_OFF);
            E.x8 = nullptr;
            pg8::gemm_phase<EpiRes, SchedDense, true>(lds + RING_OFF, S, E);
            SEAM(pb + 5);
        }
        if (layer == 0) {
            if (PH_ON(7) && IN(pb + 6)) {
                unsigned char* ws = ws_of(args); PH_TID();
                const int nc = NSPARE((T / 256) * ((2 * DFF) / 256));
                if (bx < nc) { if (!(args.flags & 1)) CONV_SLICE(2, nc); }
                SchedDense S; S.A = (const char*)(ws + WS_XB); S.Bt = (const char*)(ws + WS_WGU0); S.nM = bx < nc ? 0 : T / 256; S.nN = (2 * DFF) / 256; S.G = G - nc; S.c = bx < nc ? 0 : bx - nc; S.skip_epi = args.flags & 1; S.shape(D, D);
                EpiGU E; E.rsq = (const float*)(ws + WS_RSP) + (size_t)1 * T * 8; E.H = (bf16*)(ws + WS_H); E.ldh = DFF; E.rst = (LAS const float*)(lds + RST_OFF);
                stage_row_scales(lds, S, E.rsq, tid);
                pg8::gemm_phase<EpiGU, SchedDense, true>(lds + RING_OFF, S, E);
                SEAM(pb + 6);
            }
            if (PH_ON(8) && IN(pb + 7)) {
                unsigned char* ws = ws_of(args); PH_TID();
                SchedDense S; S.A = (const char*)(ws + WS_H); S.Bt = (const char*)(ws + WS_WD0); S.nM = T / 256; S.nN = D / 256; S.G = G; S.c = bx; S.skip_epi = args.flags & 1; S.shape(DFF, DFF);
                EpiRes E; E.xb = (bf16*)(ws + WS_XB); E.rsp_out = (float*)(ws + WS_RSP) + (size_t)2 * T * 8; E.part = (LAS float*)(lds + PART_OFF); E.x8 = ws + WS_XB8;
                pg8::gemm_phase<EpiRes, SchedDense, true>(lds + RING_OFF, S, E);
                SEAM(pb + 8);
            }
        } else {
            if (PH_ON(9) && IN(pb + 6)) {
                unsigned char* ws = ws_of(args); PH_TID();
                MoePtrs MP; MP.XB = (const bf16*)(ws + WS_XB); MP.router_w = in_of(args, 15); MP.router_b = in_of(args, 16); MP.fnw = in_of(args, 11) + D; MP.counts = (unsigned*)(ws + WS_CTL) + CW_CNT;
                MP.list = (int*)(ws + WS_LIST); MP.X8 = ws + WS_X8; MP.tslot = (int*)(ws + WS_TSLOT); MP.tw = (float*)(ws + WS_TW);
                moe_router(MP, lds, gw, NGW, wave, lane);
                SEAM(pb + 6);
            }
            if (PH_ON(10) && IN(pb + 7)) {
                unsigned char* ws = ws_of(args); PH_TID();
                SchedMoeGU S; S.X8 = (const char*)(ws + WS_X8); S.W = (const char*)(ws + WS_WGUE); S.list = (const int*)(ws + WS_LIST); S.mt.load((const unsigned*)(ws + WS_CTL) + CW_CNT); S.G = G; S.c = bx; S.skip_epi = args.flags & 1; S.ldaB = D; S.ldbB = D; S.KB = D;
                EpiGUMoe E; E.ACT8 = ws + WS_ACT; E.mt = S.mt;
                pg8::gemm_phase<EpiGUMoe, SchedMoeGU, true>(lds + RING_OFF, S, E);
                SEAM(pb + 7);
            }
            if (PH_ON(11) && IN(pb + 8)) {
                unsigned char* ws = ws_of(args); PH_TID();
                SchedMoeDN S; S.A = (const char*)(ws + WS_ACT); S.W = (const char*)(ws + WS_WDE); S.mt.load((const unsigned*)(ws + WS_CTL) + CW_CNT); S.G = G; S.c = bx; S.skip_epi = args.flags & 1; S.ldaB = DFFE; S.ldbB = DFFE; S.KB = DFFE / 2;
                EpiDnMoe E; E.YP = (bf16*)(ws + WS_YP);
                pg8::gemm_phase<EpiDnMoe, SchedMoeDN, true>(lds + RING_OFF, S, E);
                SEAM(pb + 8);
            }
        }
    }
    if (PH_ON(12) && IN(19)) {
        unsigned char* ws = ws_of(args); PH_TID();
        MoeTiles mt; mt.load((const unsigned*)(ws + WS_CTL) + CW_CNT);
        final_phase((const bf16*)(ws + WS_XB), (const bf16*)(ws + WS_YP), (const int*)(ws + WS_TSLOT), (const float*)(ws + WS_TW), mt, in_of(args, 20), args.out, gw, NGW, lane);
    }
#undef IN
#undef SEAM
#undef LP_SETUP
#undef CONV_SLICE
#undef PH_TID
}

extern "C" void kernel_launch(void* const* d_in, const int* in_sizes, int n_in, void* d_out, int out_size, void* d_ws, size_t ws_size, hipStream_t stream) {
    static int grid = 0;
    if (grid == 0) {
        if (n_in != 21 || in_sizes[0] != T * D || out_size != T * D || ws_size < WS_END) { fprintf(stderr, "kernel_launch: unexpected shapes (n_in %d, in0 %d, out %d, ws %zu < %zu); nothing launched\n", n_in, n_in > 0 ? in_sizes[0] : -1, out_size, ws_size, (size_t)WS_END); grid = -1; return; }
        int dev = 0, cus = 0, per_cu = 0;
        if (hipGetDevice(&dev) != hipSuccess || hipDeviceGetAttribute(&cus, hipDeviceAttributeMultiprocessorCount, dev) != hipSuccess) { grid = -1; return; }
        if (hipFuncSetAttribute((const void*)trunk_fwd, hipFuncAttributeMaxDynamicSharedMemorySize, LDS_BYTES) != hipSuccess) { fprintf(stderr, "kernel_launch: hipFuncSetAttribute failed\n"); grid = -1; return; }
        if (hipOccupancyMaxActiveBlocksPerMultiprocessor(&per_cu, (const void*)trunk_fwd, NWAVES * 64, LDS_BYTES) != hipSuccess || per_cu < 1) { fprintf(stderr, "kernel_launch: occupancy query says %d blocks per CU\n", per_cu); }
        (void)hipGetLastError();
        grid = cus;
    }
    if (grid < 0) return;
    if (hipMemsetAsync((char*)d_ws + WS_CTL, 0, CTL_ZERO_BYTES, stream) != hipSuccess) return;
    Args a{};
    for (int i = 0; i < 21; ++i) a.in[i] = (const float*)d_in[i];
    a.out = (float*)d_out; a.ws = (unsigned char*)d_ws;
#if MK_SPLIT
    for (int p = 0; p < N_PHASES; ++p) {
        if (p == 9) continue;
        a.ph_lo = p; a.ph_hi = p + 1;
        hipLaunchKernelGGL(trunk_fwd, dim3(grid), dim3(NWAVES * 64), LDS_BYTES, stream, a);
    }
#else
    a.ph_lo = 0; a.ph_hi = N_PHASES;
    hipLaunchKernelGGL(trunk_fwd, dim3(grid), dim3(NWAVES * 64), LDS_BYTES, stream, a);
#ifdef PROBE_EXTRA
    { const int extra[] = {PROBE_EXTRA};
      for (int k = 0; k < (int)(sizeof(extra) / sizeof(extra[0])); ++k) { a.ph_lo = extra[k] & 255; a.ph_hi = (extra[k] & 255) + 1; a.flags = extra[k] >> 8; hipLaunchKernelGGL(trunk_fwd, dim3(grid), dim3(NWAVES * 64), LDS_BYTES, stream, a); } }
#endif
#endif
}
```

```cpp
#include <hip/hip_runtime.h>
#include <cstdio>
#include <cstdint>

#define GAS __attribute__((address_space(1)))
#define LAS __attribute__((address_space(3)))
typedef unsigned short bf16;
typedef unsigned v4u __attribute__((ext_vector_type(4)));
typedef unsigned v2u __attribute__((ext_vector_type(2)));
typedef float f32x4 __attribute__((ext_vector_type(4)));
typedef float f32x2 __attribute__((ext_vector_type(2)));
typedef short bf16x8 __attribute__((ext_vector_type(8)));
typedef short s16x4 __attribute__((ext_vector_type(4)));
typedef GAS unsigned gu32;
#define RLX_AGENT __ATOMIC_RELAXED, __HIP_MEMORY_SCOPE_AGENT
#define LDS_WAIT() asm volatile("s_waitcnt lgkmcnt(0)" ::: "memory")
#define VM_WAIT() asm volatile("s_waitcnt vmcnt(0)" ::: "memory")

typedef float f32x2_t __attribute__((ext_vector_type(2)));
typedef __bf16 bf16x2_t __attribute__((ext_vector_type(2)));
__device__ __forceinline__ unsigned cvt_pk_bf16(float lo, float hi) { const f32x2_t v = {lo, hi}; return __builtin_bit_cast(unsigned, __builtin_convertvector(v, bf16x2_t)); }
__device__ __forceinline__ bf16 f2bf(float f) { return (bf16)(cvt_pk_bf16(f, 0.f) & 0xffffu); }
__device__ __forceinline__ float bf2f(bf16 b) { return __uint_as_float(((unsigned)b) << 16); }
__device__ __forceinline__ float bflo(unsigned w) { return __uint_as_float(w << 16); }
__device__ __forceinline__ float bfhi(unsigned w) { return __uint_as_float(w & 0xffff0000u); }
__device__ __forceinline__ float fast_exp(float x) { return __builtin_amdgcn_exp2f(x * 1.4426950408889634f); }
__device__ __forceinline__ float fast_log(float x) { return __builtin_amdgcn_logf(x) * 0.6931471805599453f; }
__device__ __forceinline__ float clampf(float x, float lo, float hi) { return __builtin_fminf(__builtin_fmaxf(x, lo), hi); }
__device__ __forceinline__ float sigmoidf_(float x) { return __builtin_amdgcn_rcpf(1.0f + fast_exp(-clampf(x, -80.f, 80.f))); }
__device__ __forceinline__ float siluf_(float x) { return x * sigmoidf_(x); }
constexpr float NLOG2E = -1.4426950408889634f;
__device__ __forceinline__ unsigned pack4_u8(const f32x4& s) { unsigned w = 0;
    w = __builtin_amdgcn_cvt_pk_u8_f32(__builtin_fmaxf(__builtin_rintf(s[0] * 255.f), 1.f), 0, w); w = __builtin_amdgcn_cvt_pk_u8_f32(__builtin_fmaxf(__builtin_rintf(s[1] * 255.f), 1.f), 1, w);
    w = __builtin_amdgcn_cvt_pk_u8_f32(__builtin_fmaxf(__builtin_rintf(s[2] * 255.f), 1.f), 2, w); w = __builtin_amdgcn_cvt_pk_u8_f32(__builtin_fmaxf(__builtin_rintf(s[3] * 255.f), 1.f), 3, w); return w; }
__device__ __forceinline__ f32x4 unpack4_u8(unsigned w) { return (f32x4){(float)(w & 0xffu), (float)((w >> 8) & 0xffu), (float)((w >> 16) & 0xffu), (float)(w >> 24)}; }
__device__ __forceinline__ float sig_pre(float t) { return __builtin_amdgcn_rcpf(1.0f + __builtin_amdgcn_exp2f(t)); }
__device__ __forceinline__ float wave_sum(float v) {
#pragma unroll
    for (int o = 1; o < 64; o <<= 1) v += __shfl_xor(v, o);
    return v;
}

constexpr int RING_BYTES_FWD = 131072;
namespace pg8 {
constexpr int BM = 256, BK = 64, HALF = 128, HTB = HALF * BK * 2  , STAGE_BYTES = 8 * HTB, NXCD = 8, WGM = 8;
__host__ __device__ __forceinline__ int lds_byte(int r, int c) { const int st = (r >> 4) * 2 + (c >> 5), rr = r & 15, cc = c & 31, ob = rr * 64 + cc * 2; return st * 1024 + (ob ^ (((ob >> 9) & 1) << 5)); }
__host__ __device__ __forceinline__ void stage_rc(int b, int& R, int& C) { const int st = b / 1024, sb = b % 1024, swz = sb ^ (((sb >> 9) & 1) << 5); R = (st >> 1) * 16 + swz / 64; C = (st & 1) * 32 + (swz % 64) / 2; }
__host__ __device__ __forceinline__ int perm32(int rho) { const int n = rho >> 4, i = rho & 15; return 8 * (i >> 2) + 4 * n + (i & 3); }

struct Unit { int pm, pn, aux; };

__device__ __forceinline__ bool tile_order(long L, int nM, int nN, int& pm, int& pn) {
    const int nwg = nM * nN; if (L >= nwg) return false;
    int wgid = (int)L; { const int q = nwg / NXCD, r = nwg % NXCD, xcd = wgid % NXCD, off = wgid / NXCD; wgid = (xcd < r ? xcd * (q + 1) : r * (q + 1) + (xcd - r) * q) + off; }
    const int nig = WGM * nN, gid = wgid / nig, fm = gid * WGM, gsz = (nM - fm) < WGM ? (nM - fm) : WGM;
    pm = fm + ((wgid % nig) % gsz); pn = (wgid % nig) / gsz; return true;
}

__device__ __forceinline__ const char* uni_ptr(const char* p) { const unsigned long long v = (unsigned long long)p;
    return (const char*)(((unsigned long long)(unsigned)__builtin_amdgcn_readfirstlane((int)(v >> 32)) << 32) | (unsigned)__builtin_amdgcn_readfirstlane((int)v)); }
__device__ __forceinline__ void glds16_s(const char* sbase, unsigned voff, unsigned lds_addr) {
    unsigned sv;
    asm volatile("s_mov_b32 %0, m0\n\ts_mov_b32 m0, %3\n\ts_nop 0\n\tglobal_load_lds_dwordx4 %1, %2\n\ts_mov_b32 m0, %0" : "=&s"(sv) : "v"(voff), "s"(sbase), "s"(lds_addr) : "memory");
}
typedef f32x4 Acc[2][2][4][2];
typedef int i32x4v __attribute__((ext_vector_type(4)));
typedef int i32x8v __attribute__((ext_vector_type(8)));
__device__ __forceinline__ i32x8v cat8(const bf16x8& a, const bf16x8& b) { return __builtin_shufflevector(__builtin_bit_cast(i32x4v, a), __builtin_bit_cast(i32x4v, b), 0, 1, 2, 3, 4, 5, 6, 7); }
__device__ __forceinline__ void mfma8z(f32x4& acc, const i32x8v& a, const i32x8v& b) { asm volatile("v_mfma_f32_16x16x128_f8f6f4 %0, %1, %2, 0" : "=&v"(acc) : "v"(a), "v"(b)); }
__device__ __forceinline__ void mfma8(f32x4& acc, const i32x8v& a, const i32x8v& b) { asm volatile("v_mfma_f32_16x16x128_f8f6f4 %0, %1, %2, %0" : "+v"(acc) : "v"(a), "v"(b)); }
__device__ __forceinline__ void mfma8_drain(f32x4 (&acc)[2][2][4][2]) {
    asm volatile("s_nop 15\n\ts_nop 15" : "+v"(acc[0][0][0][0]), "+v"(acc[0][0][0][1]), "+v"(acc[0][0][1][0]), "+v"(acc[0][0][1][1]), "+v"(acc[0][0][2][0]), "+v"(acc[0][0][2][1]), "+v"(acc[0][0][3][0]), "+v"(acc[0][0][3][1]),
                 "+v"(acc[0][1][0][0]), "+v"(acc[0][1][0][1]), "+v"(acc[0][1][1][0]), "+v"(acc[0][1][1][1]), "+v"(acc[0][1][2][0]), "+v"(acc[0][1][2][1]), "+v"(acc[0][1][3][0]), "+v"(acc[0][1][3][1]) :: "memory");
    asm volatile("" : "+v"(acc[1][0][0][0]), "+v"(acc[1][0][0][1]), "+v"(acc[1][0][1][0]), "+v"(acc[1][0][1][1]), "+v"(acc[1][0][2][0]), "+v"(acc[1][0][2][1]), "+v"(acc[1][0][3][0]), "+v"(acc[1][0][3][1]),
                 "+v"(acc[1][1][0][0]), "+v"(acc[1][1][0][1]), "+v"(acc[1][1][1][0]), "+v"(acc[1][1][1][1]), "+v"(acc[1][1][2][0]), "+v"(acc[1][1][2][1]), "+v"(acc[1][1][3][0]), "+v"(acc[1][1][3][1]) :: "memory");
}

template <class Epi, class Sched, bool ALIGN_EPI>
__device__ __forceinline__ void gemm_phase(LAS unsigned char* lds, const Sched& S, const Epi& E) {
    int tid_ = threadIdx.x; asm volatile("" : "+v"(tid_));
    const int tid = tid_, wid = __builtin_amdgcn_readfirstlane(tid >> 6), lane = tid & 63, wr = wid >> 2, wc = wid & 3, fr = lane & 15, fq = lane >> 4;
    const int nt = S.KB / 128;
    int Rr[2], Cc[2]; unsigned voffB[2], voffA[2][2], nvoffA[2][2];
#pragma unroll
    for (int i = 0; i < 2; ++i) { stage_rc(tid * 16 + i * 8192, Rr[i], Cc[i]); const int Rb = Epi::PERM ? ((Rr[i] & ~31) + perm32(Rr[i] & 31)) : Rr[i];
        voffB[i] = (unsigned)(Rb * S.ldbB + Cc[i] * 2);
        voffA[0][i] = (unsigned)(Rr[i] * S.ldaB + Cc[i] * 2); voffA[1][i] = (unsigned)((Rr[i] + HALF) * S.ldaB + Cc[i] * 2); nvoffA[0][i] = voffA[0][i]; nvoffA[1][i] = voffA[1][i]; }
    const size_t kstep = (size_t)128;
    const size_t hstepB = (size_t)HALF * S.ldbB;
    const unsigned ldsb = (unsigned)__builtin_amdgcn_readfirstlane((int)((unsigned)(uintptr_t)lds + (unsigned)wid * 1024u));
    const int aoff = lds_byte(wr * 64 + fr, fq * 8), boff = lds_byte(wc * 32 + fr, fq * 8);
#define PG8_SA(b, h) (((b) * 2 + (h)) * HTB)
#define PG8_SB(b, h) ((4 + (b) * 2 + (h)) * HTB)
#define PG8_STAGE(bufoff, gbase, voff) do { _Pragma("unroll") for (int _i = 0; _i < 2; ++_i) glds16_s((gbase), (voff)[_i], ldsb + (unsigned)((bufoff) + _i * 8192)); } while (0)
#define PG8_LDA(dst, b, h) do { _Pragma("unroll") for (int m = 0; m < 4; ++m) _Pragma("unroll") for (int k = 0; k < 2; ++k) dst[m][k] = *(const LAS bf16x8*)(lds + PG8_SA(b, h) + aoff + m * 2048 + k * 1024); } while (0)
#define PG8_LDB(dst, b, h) do { _Pragma("unroll") for (int n = 0; n < 2; ++n) _Pragma("unroll") for (int k = 0; k < 2; ++k) dst[n][k] = *(const LAS bf16x8*)(lds + PG8_SB(b, h) + boff + n * 2048 + k * 1024); } while (0)
#define PG8_MMA(ai, bj, At, Bt) do { __builtin_amdgcn_s_setprio(1); _Pragma("unroll") for (int m = 0; m < 4; ++m) _Pragma("unroll") for (int n = 0; n < 2; ++n) { \
        if constexpr (Sched::FP8) { mfma8(acc[ai][bj][m][n], cat8(Bt[n][0], Bt[n][1]), cat8(At[m][0], At[m][1])); } \
        else { _Pragma("unroll") for (int k = 0; k < 2; ++k) acc[ai][bj][m][n] = __builtin_amdgcn_mfma_f32_16x16x32_bf16(Bt[n][k], At[m][k], acc[ai][bj][m][n], 0, 0, 0); } } \
        __builtin_amdgcn_s_setprio(0); } while (0)
#define PG8_MMA_Z(ai, bj, At, Bt) do { __builtin_amdgcn_s_setprio(1); _Pragma("unroll") for (int m = 0; m < 4; ++m) _Pragma("unroll") for (int n = 0; n < 2; ++n) { \
        if constexpr (Sched::FP8) { mfma8z(acc[ai][bj][m][n], cat8(Bt[n][0], Bt[n][1]), cat8(At[m][0], At[m][1])); } \
        else { acc[ai][bj][m][n] = __builtin_amdgcn_mfma_f32_16x16x32_bf16(Bt[n][0], At[m][0], (f32x4){0.f, 0.f, 0.f, 0.f}, 0, 0, 0); \
               acc[ai][bj][m][n] = __builtin_amdgcn_mfma_f32_16x16x32_bf16(Bt[n][1], At[m][1], acc[ai][bj][m][n], 0, 0, 0); } } \
        __builtin_amdgcn_s_setprio(0); } while (0)
#define PG8_WAIT_V(n) asm volatile("s_waitcnt vmcnt(" #n ")" ::: "memory")
#define PG8_WAIT_L(n) asm volatile("s_waitcnt lgkmcnt(" #n ")" ::: "memory")
#define PG8_BAR __builtin_amdgcn_s_barrier()
#define PG8_SCHED __builtin_amdgcn_sched_barrier(0)
#define PG8_KBODY(t, MMAF) do { \
            const bool last = (t == nt - 2); \
            const char* a1 = cA + (size_t)(t + 1) * kstep; \
            const char* a2 = last ? nA : cA + (size_t)(t + 2) * kstep; const char* b2 = last ? nB : cB + (size_t)(t + 2) * kstep; \
            const char* a3 = a2 + kstep; const char* b3 = b2 + kstep; \
            unsigned o2[2][2]; \
            _Pragma("unroll") \
            for (int h = 0; h < 2; ++h) \
            _Pragma("unroll") \
                for (int i = 0; i < 2; ++i) o2[h][i] = (Sched::GATHER && last) ? nvoffA[h][i] : voffA[h][i]; \
            PG8_LDB(B0, 0, 0); PG8_LDB(B1, 0, 1); PG8_SCHED; PG8_LDA(At, 0, 0); PG8_STAGE(PG8_SA(1, 1), a1, voffA[1]); \
            PG8_WAIT_V(8); PG8_WAIT_L(0); PG8_BAR; MMAF(0, 0, At, B0); MMAF(0, 1, At, B1); PG8_BAR; PG8_SCHED; \
            PG8_LDA(At, 0, 1); PG8_STAGE(PG8_SB(0, 0), b2, voffB); PG8_STAGE(PG8_SB(0, 1), b2 + hstepB, voffB); PG8_STAGE(PG8_SA(0, 0), a2, o2[0]); \
            PG8_WAIT_V(8); PG8_WAIT_L(0); PG8_BAR; MMAF(1, 0, At, B0); MMAF(1, 1, At, B1); PG8_BAR; PG8_SCHED; \
            PG8_LDB(B0, 1, 0); PG8_LDB(B1, 1, 1); PG8_SCHED; PG8_LDA(At, 1, 0); PG8_STAGE(PG8_SA(0, 1), a2, o2[1]); \
            PG8_WAIT_V(8); PG8_WAIT_L(0); PG8_BAR; PG8_MMA(0, 0, At, B0); PG8_MMA(0, 1, At, B1); PG8_BAR; PG8_SCHED; \
            PG8_LDA(At, 1, 1); PG8_STAGE(PG8_SB(1, 0), b3, voffB); PG8_STAGE(PG8_SB(1, 1), b3 + hstepB, voffB); PG8_STAGE(PG8_SA(1, 0), a3, o2[0]); \
            PG8_WAIT_V(8); PG8_WAIT_L(0); PG8_BAR; PG8_MMA(1, 0, At, B0); PG8_MMA(1, 1, At, B1); PG8_BAR; PG8_SCHED; \
        } while (0)
    Unit cur, nxt; int ui = 0;
    if (!S.next(0, cur)) return;
    Acc acc;
#pragma unroll
    for (int a = 0; a < 2; ++a)
#pragma unroll
        for (int b = 0; b < 2; ++b)
#pragma unroll
            for (int m = 0; m < 4; ++m)
#pragma unroll
                for (int n = 0; n < 2; ++n) acc[a][b][m][n] = (f32x4){0.f, 0.f, 0.f, 0.f};
    bf16x8 At[4][2], B0[2][2], B1[2][2];
    const char* cA = uni_ptr(S.a_base(cur)); const char* cB = uni_ptr(S.b_base(cur));
    if constexpr (Sched::GATHER) S.a_offs(cur, Rr, Cc, voffA);
    PG8_STAGE(PG8_SB(0, 0), cB, voffB); PG8_STAGE(PG8_SB(0, 1), cB + hstepB, voffB); PG8_STAGE(PG8_SA(0, 0), cA, voffA[0]); PG8_STAGE(PG8_SA(0, 1), cA, voffA[1]);
    if (wr == 1) PG8_BAR;
    PG8_WAIT_V(2); PG8_BAR;
    PG8_STAGE(PG8_SB(1, 0), cB + kstep, voffB); PG8_STAGE(PG8_SA(1, 0), cA + kstep, voffA[0]); PG8_STAGE(PG8_SB(1, 1), cB + hstepB + kstep, voffB);
    PG8_WAIT_V(6); PG8_BAR;
    for (;;) {
        const bool has_next = S.next(ui + 1, nxt);
        const char* nA = uni_ptr(has_next ? S.a_base(nxt) : cA); const char* nB = uni_ptr(has_next ? S.b_base(nxt) : cB);
        if constexpr (Sched::GATHER) { if (has_next) S.a_offs(nxt, Rr, Cc, nvoffA); else {
#pragma unroll
            for (int i = 0; i < 2; ++i) { nvoffA[0][i] = voffA[0][i]; nvoffA[1][i] = voffA[1][i]; } } }
        if constexpr (Epi::ZERO_RESET) { PG8_KBODY(0, PG8_MMA_Z); for (int t = 2; t < nt; t += 2) PG8_KBODY(t, PG8_MMA); }
        else { for (int t = 0; t < nt; t += 2) PG8_KBODY(t, PG8_MMA); }
        if constexpr (Sched::FP8) mfma8_drain(acc);
        if constexpr (ALIGN_EPI) { if (wr == 0) PG8_BAR; }
        {
          int tz = threadIdx.x; asm volatile("" : "+v"(tz)); const int wz = __builtin_amdgcn_readfirstlane(tz >> 6), lz = tz & 63;
          if (!S.skip_epi) E(acc, cur, wz >> 2, wz & 3, lz & 15, lz >> 4);
          if (!has_next) break;
          if constexpr (!Epi::ZERO_RESET) E.reset(acc, cur, wz >> 2, wz & 3, lz & 15, lz >> 4); }
        cur = nxt; cA = nA; cB = nB; ++ui;
        if constexpr (Sched::GATHER) {
#pragma unroll
            for (int i = 0; i < 2; ++i) { voffA[0][i] = nvoffA[0][i]; voffA[1][i] = nvoffA[1][i]; } }
        if constexpr (ALIGN_EPI) { if (wr == 1) PG8_BAR; }
    }
    PG8_WAIT_V(0);
    if constexpr (!ALIGN_EPI) { if (wr == 0) PG8_BAR; }
    PG8_BAR;
#undef PG8_KBODY
#undef PG8_MMA_Z
#undef PG8_SA
#undef PG8_SB
#undef PG8_STAGE
#undef PG8_LDA
#undef PG8_LDB
#undef PG8_MMA
#undef PG8_WAIT_V
#undef PG8_WAIT_L
#undef PG8_BAR
#undef PG8_SCHED
}
}
constexpr int T = 8192, D = 2048, DEPTH = 2;
constexpr int NIN_BF = 30;
constexpr int NIN = 11776;
constexpr int DIN_SRC = 11280;
constexpr int DFF = 5632, DFFE = 7168, NE = 8;
constexpr int QK_LD = 1536, V_LD = 2048, M_LD = 4096;
constexpr int NCH = 128, CH = 64, NHEADS = 12;
constexpr int STATE_E = 262144;
constexpr float EPS = 1e-6f;
constexpr float QSCALE = 0.08838834764831845f;
constexpr int MOE_CAP = 8192;
constexpr int MOE_MAXT = 72;

template <bool F8> struct SchedDenseT {
    static constexpr bool GATHER = false, FP8 = F8;
    const char* A; const char* Bt; int nM, nN, G, c, ldaB, ldbB, KB, skip_epi;
    __device__ __forceinline__ void shape(int lda, int K) { const int es = F8 ? 1 : 2; ldaB = lda * es; ldbB = K * es; KB = K * es; }
    __device__ __forceinline__ bool next(int i, pg8::Unit& u) const { u.aux = i; return pg8::tile_order((long)i * G + c, nM, nN, u.pm, u.pn); }
    __device__ __forceinline__ const char* a_base(const pg8::Unit& u) const { return A + (size_t)u.pm * 256 * ldaB; }
    __device__ __forceinline__ const char* b_base(const pg8::Unit& u) const { return Bt + (size_t)u.pn * 256 * ldbB; }
    __device__ __forceinline__ void a_offs(const pg8::Unit&, const int (&)[2], const int (&)[2], unsigned (&)[2][2]) const {}
};
typedef SchedDenseT<false> SchedDense;
typedef SchedDenseT<true> SchedDense8;
struct SchedProj {
    static constexpr bool GATHER = false, FP8 = false;
    const char* Y; const char* Wa; const char* Wb; int G, c, ldaB, ldbB, KB, skip_epi;
    __device__ __forceinline__ bool next(int i, pg8::Unit& u) const { u.aux = i & 1; return pg8::tile_order((long)(i >> 1) * G + c, T / 256, D / 256, u.pm, u.pn); }
    __device__ __forceinline__ const char* a_base(const pg8::Unit& u) const { return Y + (size_t)u.pm * 256 * ldaB + (u.aux ? 1024 * 2 : 0); }
    __device__ __forceinline__ const char* b_base(const pg8::Unit& u) const { return (u.aux ? Wb : Wa) + (size_t)u.pn * 256 * ldbB; }
    __device__ __forceinline__ void a_offs(const pg8::Unit&, const int (&)[2], const int (&)[2], unsigned (&)[2][2]) const {}
};
typedef int i32x8 __attribute__((ext_vector_type(8)));
struct MoeTiles {
    i32x8 cnt, tb; int ntiles;
    __device__ __forceinline__ void load(const unsigned* counts_) {
        int s = 0;
#pragma unroll
        for (int e = 0; e < NE; ++e) { int c = (int)__hip_atomic_load((unsigned*)counts_ + e, RLX_AGENT); c = c < 0 ? 0 : (c > MOE_CAP ? MOE_CAP : c); c = __builtin_amdgcn_readfirstlane(c); cnt[e] = c; tb[e] = s; s += (c + 255) >> 8; }
        ntiles = s;
    }
    __device__ __forceinline__ int expert_of(int pm) const {
        return (pm >= tb[1] ? 1 : 0) + (pm >= tb[2] ? 1 : 0) + (pm >= tb[3] ? 1 : 0) + (pm >= tb[4] ? 1 : 0) + (pm >= tb[5] ? 1 : 0) + (pm >= tb[6] ? 1 : 0) + (pm >= tb[7] ? 1 : 0); }
    __device__ __forceinline__ int cnt_of(int e) const { int c = cnt[0]; c = e == 1 ? cnt[1] : c; c = e == 2 ? cnt[2] : c; c = e == 3 ? cnt[3] : c; c = e == 4 ? cnt[4] : c; c = e == 5 ? cnt[5] : c; c = e == 6 ? cnt[6] : c; c = e == 7 ? cnt[7] : c; return c; }
    __device__ __forceinline__ int tb_of(int e) const { int c = tb[0]; c = e == 1 ? tb[1] : c; c = e == 2 ? tb[2] : c; c = e == 3 ? tb[3] : c; c = e == 4 ? tb[4] : c; c = e == 5 ? tb[5] : c; c = e == 6 ? tb[6] : c; c = e == 7 ? tb[7] : c; return c; }
};
struct SchedMoeGU {
    static constexpr bool GATHER = true, FP8 = true;
    const char* X8; const char* W; const int* list; MoeTiles mt; int G, c, ldaB, ldbB, KB, skip_epi;
    __device__ __forceinline__ bool next(int i, pg8::Unit& u) const {
        if (!pg8::tile_order((long)i * G + c, mt.ntiles, (2 * DFFE) / 256, u.pm, u.pn)) return false;
        const int e = mt.expert_of(u.pm); u.aux = e | ((u.pm - mt.tb_of(e)) << 8); return true; }
    __device__ __forceinline__ const char* a_base(const pg8::Unit&) const { return X8; }
    __device__ __forceinline__ const char* b_base(const pg8::Unit& u) const { return W + (size_t)(u.aux & 255) * ((size_t)2 * DFFE * D) + (size_t)u.pn * 256 * ldbB; }
    __device__ __forceinline__ void a_offs(const pg8::Unit& u, const int (&R)[2], const int (&C)[2], unsigned (&voff)[2][2]) const {
        const int e = u.aux & 255, lt = u.aux >> 8, n = mt.cnt_of(e);
        int tk[2][2];
#pragma unroll
        for (int h = 0; h < 2; ++h)
#pragma unroll
            for (int i = 0; i < 2; ++i) { const int pos = lt * 256 + h * 128 + R[i]; tk[h][i] = list[e * MOE_CAP + (pos < n ? pos : 0)]; }
        asm volatile("" : "+v"(tk[0][0]), "+v"(tk[0][1]), "+v"(tk[1][0]), "+v"(tk[1][1]));
#pragma unroll
        for (int h = 0; h < 2; ++h)
#pragma unroll
            for (int i = 0; i < 2; ++i) { const int pos = lt * 256 + h * 128 + R[i]; const int tok = pos < n ? tk[h][i] : 0; voff[h][i] = (unsigned)(tok * D + C[i] * 2); }
    }
};
struct SchedMoeDN {
    static constexpr bool GATHER = false, FP8 = true;
    const char* A; const char* W; MoeTiles mt; int G, c, ldaB, ldbB, KB, skip_epi;
    __device__ __forceinline__ bool next(int i, pg8::Unit& u) const {
        int pn2; if (!pg8::tile_order((long)i * G + c, mt.ntiles, 2 * (D / 256), u.pm, pn2)) return false;
        u.pn = pn2 >> 1; u.aux = mt.expert_of(u.pm) | ((pn2 & 1) << 8); return true; }
    __device__ __forceinline__ const char* a_base(const pg8::Unit& u) const { return A + (size_t)u.pm * 256 * ldaB + (size_t)(u.aux >> 8) * KB; }
    __device__ __forceinline__ const char* b_base(const pg8::Unit& u) const { return W + (size_t)(u.aux & 255) * ((size_t)D * DFFE) + (size_t)u.pn * 256 * ldbB + (size_t)(u.aux >> 8) * KB; }
    __device__ __forceinline__ void a_offs(const pg8::Unit&, const int (&)[2], const int (&)[2], unsigned (&)[2][2]) const {}
};

__device__ __forceinline__ void acc_zero(pg8::Acc& acc) {
#pragma unroll
    for (int a = 0; a < 2; ++a)
#pragma unroll
        for (int b = 0; b < 2; ++b)
#pragma unroll
            for (int m = 0; m < 4; ++m)
#pragma unroll
                for (int n = 0; n < 2; ++n) acc[a][b][m][n] = (f32x4){0.f, 0.f, 0.f, 0.f};
}
__device__ __forceinline__ v4u pack8(const f32x4& a, const f32x4& b) { v4u w; w.x = cvt_pk_bf16(a[0], a[1]); w.y = cvt_pk_bf16(a[2], a[3]); w.z = cvt_pk_bf16(b[0], b[1]); w.w = cvt_pk_bf16(b[2], b[3]); return w; }

__device__ __forceinline__ float row_scale(const float* rsp, size_t row) {
    const f32x4 a = *(const f32x4*)(rsp + row * 8), b = *(const f32x4*)(rsp + row * 8 + 4);
    return __builtin_amdgcn_rsqf((((a[0] + a[1]) + (a[2] + a[3])) + ((b[0] + b[1]) + (b[2] + b[3]))) * (1.0f / D) + EPS);
}
constexpr float W8_SCALE = 64.f, ACT8_SCALE = 16.f;
__device__ __forceinline__ float clamp8(float x) { return __builtin_fminf(__builtin_fmaxf(x, -448.f), 448.f); }
__device__ __forceinline__ unsigned pack4_fp8(float a, float b, float c, float d) { int w = 0; w = __builtin_amdgcn_cvt_pk_fp8_f32(clamp8(a), clamp8(b), w, false); w = __builtin_amdgcn_cvt_pk_fp8_f32(clamp8(c), clamp8(d), w, true); return (unsigned)w; }
constexpr float X8_SCALE = 4.f;
struct RowScales { float v[8]; };
constexpr int LBL_OFF = RING_BYTES_FWD + 12288;
constexpr int RST_OFF = RING_BYTES_FWD + 6144;
template <class Sched> __device__ __forceinline__ void stage_row_scales(LAS unsigned char* lds, const Sched& S, const float* rsp, int tid) {
    LAS float* tab = (LAS float*)(lds + RST_OFF);
    if (tid < 256) { f32x4 a[6], b[6];
#pragma unroll
        for (int i = 0; i < 6; ++i) { pg8::Unit u; const bool ok = S.next(i, u); const size_t row = (size_t)((ok ? u.pm : 0) * 256 + tid); a[i] = *(const f32x4*)(rsp + row * 8); b[i] = *(const f32x4*)(rsp + row * 8 + 4); }
#pragma unroll
        for (int i = 0; i < 6; ++i) tab[i * 256 + tid] = __builtin_amdgcn_rsqf((((a[i][0] + a[i][1]) + (a[i][2] + a[i][3])) + ((b[i][0] + b[i][1]) + (b[i][2] + b[i][3]))) * (1.0f / D) + EPS); }
    __syncthreads();
}
__device__ __forceinline__ void row_scales8_lds(RowScales& R, LAS const float* tab, const pg8::Unit& u, int row0) {
    const int base = u.aux * 256 + (row0 - u.pm * 256);
#pragma unroll
    for (int g = 0; g < 8; ++g) R.v[g] = tab[base + (g >> 2) * 128 + (g & 3) * 16];
}
__device__ __forceinline__ void row_scales8(RowScales& R, const float* rsp, int row0) {
#pragma unroll
    for (int h = 0; h < 2; ++h) { f32x4 a[4], b[4];
#pragma unroll
        for (int g = 0; g < 4; ++g) { const size_t row = (size_t)(row0 + h * 128 + g * 16); a[g] = *(const f32x4*)(rsp + row * 8); b[g] = *(const f32x4*)(rsp + row * 8 + 4); }
#pragma unroll
        for (int g = 0; g < 4; ++g) R.v[4 * h + g] = __builtin_amdgcn_rsqf((((a[g][0] + a[g][1]) + (a[g][2] + a[g][3])) + ((b[g][0] + b[g][1]) + (b[g][2] + b[g][3]))) * (1.0f / D) + EPS);
        asm volatile("" ::: "memory"); }
}
struct EpiIn {
    static constexpr bool PERM = true, ZERO_RESET = false;
    const float* rsq;
    LAS const float* rst;
    LAS const float* lbl;
    bf16 *Q, *Kb, *V, *SG, *M; float* Gf; const float* lbv; const float* gkb;
    __device__ __forceinline__ void operator()(const pg8::Acc& acc, const pg8::Unit& u, int wr, int wc, int fr, int fq) const {
        const int pn = u.pn, row0 = u.pm * 256 + wr * 64 + fr, cl = wc * 32 + 8 * fq;
        int mode, ld, col0; int sel; float sc = 1.f;
        if (pn < 4)       { mode = 0; sel = 0; ld = QK_LD; col0 = 256 * pn; sc = QSCALE; }
        else if (pn < 8)  { mode = 3; sel = 1; ld = QK_LD; col0 = 256 * (pn - 4); }
        else if (pn < 12) { mode = 0; sel = 2; ld = V_LD;  col0 = 256 * (pn - 8); }
        else if (pn < 16) { mode = 1; sel = 3; ld = V_LD;  col0 = 256 * (pn - 12); }
        else if (pn < 18) { mode = 0; sel = 0; ld = QK_LD; col0 = 1024 + 256 * (pn - 16); sc = QSCALE; }
        else if (pn < 20) { mode = 0; sel = 1; ld = QK_LD; col0 = 1024 + 256 * (pn - 18); }
        else if (pn < 24) { mode = 0; sel = 2; ld = V_LD;  col0 = 1024 + 256 * (pn - 20); }
        else if (pn < 28) { mode = 1; sel = 3; ld = V_LD;  col0 = 1024 + 256 * (pn - 24); }
        else              { mode = 4; sel = 0; ld = QK_LD; col0 = 1024 + 256 * (pn - 28); }
        const size_t doff = sel == 0 ? (size_t)0 : sel == 1 ? (size_t)((const char*)Kb - (const char*)Q) : sel == 2 ? (size_t)((const char*)V - (const char*)Q) : (size_t)((const char*)SG - (const char*)Q);
        bf16* dst = (bf16*)((char*)Q + doff);
        RowScales RS; row_scales8_lds(RS, rst, u, row0);
#define RS_AT(ai, m) RS.v[(ai) * 4 + (m)]
        if (mode <= 1) {
#pragma unroll
            for (int ai = 0; ai < 2; ++ai)
#pragma unroll
                for (int m = 0; m < 4; ++m) { const float r = RS_AT(ai, m) * sc, nr = r * NLOG2E; bf16* rowp = dst + (size_t)(row0 + ai * 128 + m * 16) * ld + col0 + cl;
#pragma unroll
                    for (int bj = 0; bj < 2; ++bj) { f32x4 v0 = acc[ai][bj][m][0] * r, v1 = acc[ai][bj][m][1] * r;
                        if (mode == 1) { const f32x4 t0 = acc[ai][bj][m][0] * nr, t1 = acc[ai][bj][m][1] * nr;
#pragma unroll
                            for (int j = 0; j < 4; ++j) { v0[j] *= sig_pre(t0[j]); v1[j] *= sig_pre(t1[j]); } }
                        *(v4u*)(rowp + bj * 128) = pack8(v0, v1); } }
        } else if (mode == 3) {
#pragma unroll
            for (int bj = 0; bj < 2; ++bj) {
                const f32x4 lb0 = *(LAS const f32x4*)(lbl + col0 + bj * 128 + cl), lb1 = *(LAS const f32x4*)(lbl + col0 + bj * 128 + cl + 4); const f32x4 om0 = 1.f - lb0, om1 = 1.f - lb1;
#pragma unroll
                for (int ai = 0; ai < 2; ++ai)
#pragma unroll
                    for (int m = 0; m < 4; ++m) { const float nr = RS_AT(ai, m) * NLOG2E; const size_t ro = (size_t)(row0 + ai * 128 + m * 16) * QK_LD + col0 + bj * 128 + cl;
                        f32x4 g0, g1, k0, k1;
#pragma unroll
                        for (int j = 0; j < 4; ++j) {
                            { const float t = __builtin_amdgcn_exp2f(clampf(acc[ai][bj][m][0][j] * nr, -115.f, 115.f)), s = __builtin_amdgcn_rcpf(1.f + t), om = om0[j]; g0[j] = fast_log(__builtin_fmaf(om, s, lb0[j])); k0[j] = __builtin_fmaf(-om, s, om); }
                            { const float t = __builtin_amdgcn_exp2f(clampf(acc[ai][bj][m][1][j] * nr, -115.f, 115.f)), s = __builtin_amdgcn_rcpf(1.f + t), om = om1[j]; g1[j] = fast_log(__builtin_fmaf(om, s, lb1[j])); k1[j] = __builtin_fmaf(-om, s, om); } }
                        *(f32x4*)(Gf + ro) = g0; *(f32x4*)(Gf + ro + 4) = g1; *(v4u*)(Kb + ro) = pack8(k0, k1); } }
        } else {
#pragma unroll
            for (int bj = 0; bj < 2; ++bj) {
                const f32x4 b0 = *(const f32x4*)(gkb + (col0 - 1024) + bj * 128 + cl), b1 = *(const f32x4*)(gkb + (col0 - 1024) + bj * 128 + cl + 4);
#pragma unroll
                for (int ai = 0; ai < 2; ++ai)
#pragma unroll
                    for (int m = 0; m < 4; ++m) { const float r = RS_AT(ai, m); const size_t ro = (size_t)(row0 + ai * 128 + m * 16) * QK_LD + col0 + bj * 128 + cl;
                        f32x4 g0, g1;
#pragma unroll
                        for (int j = 0; j < 4; ++j) {
                            { const float z = clampf(acc[ai][bj][m][0][j] * r + b0[j], -80.f, 80.f); g0[j] = -fast_log(1.f + fast_exp(-z)) * (1.f / 16.f); }
                            { const float z = clampf(acc[ai][bj][m][1][j] * r + b1[j], -80.f, 80.f); g1[j] = -fast_log(1.f + fast_exp(-z)) * (1.f / 16.f); } }
                        *(f32x4*)(Gf + ro) = g0; *(f32x4*)(Gf + ro + 4) = g1; } }
        }
    }
    __device__ __forceinline__ void reset(pg8::Acc& acc, const pg8::Unit&, int, int, int, int) const { acc_zero(acc); }
};

struct EpiIn8 {
    static constexpr bool PERM = true, ZERO_RESET = false;
    const float* rsq; unsigned char* M; LAS const float* rst;
    __device__ __forceinline__ void operator()(const pg8::Acc& acc, const pg8::Unit& u, int wr, int wc, int fr, int fq) const {
        const int row0 = u.pm * 256 + wr * 64 + fr, col0 = u.pn * 256 + wc * 32 + 8 * fq;
        RowScales RS; row_scales8_lds(RS, rst, u, row0);
#pragma unroll
        for (int ai = 0; ai < 2; ++ai)
#pragma unroll
            for (int m = 0; m < 4; ++m) { const size_t r = (size_t)(row0 + ai * 128 + m * 16); const float rs = RS.v[ai * 4 + m] * (NLOG2E / (W8_SCALE * X8_SCALE));
#pragma unroll
                for (int bj = 0; bj < 2; ++bj) { f32x4 v0 = acc[ai][bj][m][0] * rs, v1 = acc[ai][bj][m][1] * rs;
#pragma unroll
                    for (int j = 0; j < 4; ++j) { v0[j] = sig_pre(v0[j]); v1[j] = sig_pre(v1[j]); }
                    v2u w; w.x = pack4_u8(v0); w.y = pack4_u8(v1); *(v2u*)(M + r * M_LD + col0 + bj * 128) = w; }
                asm volatile("" ::: "memory"); }
    }
    __device__ __forceinline__ void reset(pg8::Acc& acc, const pg8::Unit&, int, int, int, int) const { acc_zero(acc); }
};
struct EpiProj {
    static constexpr bool PERM = true, ZERO_RESET = false;
    const unsigned char* M; bf16* MG;
    __device__ __forceinline__ void operator()(const pg8::Acc& acc, const pg8::Unit& u, int wr, int wc, int fr, int fq) const {
        if (u.aux == 0) return;
        const int row0 = u.pm * 256 + wr * 64 + fr, col0 = u.pn * 256 + wc * 32 + 8 * fq;
        v2u ngb[2], ngb2[2];
#pragma unroll
        for (int bj = 0; bj < 2; ++bj) { ngb[bj] = *(const v2u*)(M + (size_t)row0 * M_LD + 2048 + col0 + bj * 128); ngb2[bj] = *(const v2u*)(M + (size_t)(row0 + 16) * M_LD + 2048 + col0 + bj * 128); }
#pragma unroll
        for (int ai = 0; ai < 2; ++ai)
#pragma unroll
            for (int m = 0; m < 4; ++m) { const size_t r = (size_t)(row0 + ai * 128 + m * 16);
                v2u cgb[2]; cgb[0] = ngb[0]; cgb[1] = ngb[1]; ngb[0] = ngb2[0]; ngb[1] = ngb2[1];
                if (ai * 4 + m < 6) { const int gn = ai * 4 + m + 2; const size_t rn = (size_t)(row0 + (gn >> 2) * 128 + (gn & 3) * 16);
#pragma unroll
                    for (int bj = 0; bj < 2; ++bj) ngb2[bj] = *(const v2u*)(M + rn * M_LD + 2048 + col0 + bj * 128); }
#pragma unroll
                for (int bj = 0; bj < 2; ++bj) { const v2u gb = cgb[bj];
                    const f32x4 v0 = acc[ai][bj][m][0] * unpack4_u8(gb.x) * (1.0f / 255.f), v1 = acc[ai][bj][m][1] * unpack4_u8(gb.y) * (1.0f / 255.f);
                    *(v4u*)(MG + r * D + col0 + bj * 128) = pack8(v0, v1); }
                asm volatile("" ::: "memory"); }
    }
    __device__ __forceinline__ void reset(pg8::Acc& acc, const pg8::Unit& u, int wr, int wc, int fr, int fq) const {
        const float keep = u.aux == 0 ? 1.f : 0.f;
        const int row0 = u.pm * 256 + wr * 64 + fr, col0 = u.pn * 256 + wc * 32 + 8 * fq;
        v2u nga[2], ngb[2], nga2[2], ngb2[2];
#pragma unroll
        for (int bj = 0; bj < 2; ++bj) { nga[bj] = *(const v2u*)(M + (size_t)row0 * M_LD + col0 + bj * 128); ngb[bj] = *(const v2u*)(M + (size_t)row0 * M_LD + 2048 + col0 + bj * 128);
            nga2[bj] = *(const v2u*)(M + (size_t)(row0 + 16) * M_LD + col0 + bj * 128); ngb2[bj] = *(const v2u*)(M + (size_t)(row0 + 16) * M_LD + 2048 + col0 + bj * 128); }
#pragma unroll
        for (int ai = 0; ai < 2; ++ai)
#pragma unroll
            for (int m = 0; m < 4; ++m) {
                v2u cga[2], cgb[2]; cga[0] = nga[0]; cga[1] = nga[1]; cgb[0] = ngb[0]; cgb[1] = ngb[1]; nga[0] = nga2[0]; nga[1] = nga2[1]; ngb[0] = ngb2[0]; ngb[1] = ngb2[1];
                if (ai * 4 + m < 6) { const int gn = ai * 4 + m + 2; const size_t rn = (size_t)(row0 + (gn >> 2) * 128 + (gn & 3) * 16);
#pragma unroll
                    for (int bj = 0; bj < 2; ++bj) { nga2[bj] = *(const v2u*)(M + rn * M_LD + col0 + bj * 128); ngb2[bj] = *(const v2u*)(M + rn * M_LD + 2048 + col0 + bj * 128); } }
#pragma unroll
                for (int bj = 0; bj < 2; ++bj) { const f32x4 a0 = unpack4_u8(cga[bj].x), a1 = unpack4_u8(cga[bj].y), b0 = unpack4_u8(cgb[bj].x), b1 = unpack4_u8(cgb[bj].y);
#pragma unroll
                    for (int j = 0; j < 4; ++j) { acc[ai][bj][m][0][j] *= keep * a0[j] * __builtin_amdgcn_rcpf(b0[j]); acc[ai][bj][m][1][j] *= keep * a1[j] * __builtin_amdgcn_rcpf(b1[j]); } }
                asm volatile("" : "+v"(acc[ai][0][m][0]), "+v"(acc[ai][0][m][1]), "+v"(acc[ai][1][m][0]), "+v"(acc[ai][1][m][1]));
                asm volatile("" ::: "memory"); }
    }
};

struct EpiRes {
    static constexpr bool PERM = true, ZERO_RESET = false;
    bf16* xb; float* rsp_out; LAS float* part;
    unsigned char* x8;
    __device__ __forceinline__ void operator()(const pg8::Acc& acc, const pg8::Unit& u, int wr, int wc, int fr, int fq) const {
        const int row0 = u.pm * 256 + wr * 64 + fr, col0 = u.pn * 256 + wc * 32 + 8 * fq;
        v4u nx[2], nx2[2];
#pragma unroll
        for (int bj = 0; bj < 2; ++bj) { nx[bj] = *(const v4u*)(xb + (size_t)row0 * D + col0 + bj * 128); nx2[bj] = *(const v4u*)(xb + (size_t)(row0 + 16) * D + col0 + bj * 128); }
#pragma unroll
        for (int ai = 0; ai < 2; ++ai)
#pragma unroll
            for (int m = 0; m < 4; ++m) { const size_t r = (size_t)(row0 + ai * 128 + m * 16); float ss = 0.f;
                v4u cx[2];
#pragma unroll
                for (int q = 0; q < 2; ++q) { cx[q] = nx[q]; nx[q] = nx2[q]; }
                if (ai * 4 + m < 6) { const int gn = ai * 4 + m + 2; const size_t rn = (size_t)(row0 + (gn >> 2) * 128 + (gn & 3) * 16);
#pragma unroll
                    for (int bj = 0; bj < 2; ++bj) nx2[bj] = *(const v4u*)(xb + rn * D + col0 + bj * 128); }
#pragma unroll
                for (int bj = 0; bj < 2; ++bj) { const size_t o = r * D + col0 + bj * 128; const v4u c = cx[bj];
                    const f32x4 x0 = (f32x4){bflo(c.x), bfhi(c.x), bflo(c.y), bfhi(c.y)} + acc[ai][bj][m][0], x1 = (f32x4){bflo(c.z), bfhi(c.z), bflo(c.w), bfhi(c.w)} + acc[ai][bj][m][1];
                    *(v4u*)(xb + o) = pack8(x0, x1);
                    if (x8) { v2u w; w.x = pack4_fp8(x0[0] * X8_SCALE, x0[1] * X8_SCALE, x0[2] * X8_SCALE, x0[3] * X8_SCALE); w.y = pack4_fp8(x1[0] * X8_SCALE, x1[1] * X8_SCALE, x1[2] * X8_SCALE, x1[3] * X8_SCALE); *(v2u*)(x8 + o) = w; }
                    ss += (x0[0] * x0[0] + x0[1] * x0[1]) + (x0[2] * x0[2] + x0[3] * x0[3]) + (x1[0] * x1[0] + x1[1] * x1[1]) + (x1[2] * x1[2] + x1[3] * x1[3]); }
                ss += __shfl_xor(ss, 16); ss += __shfl_xor(ss, 32);
                if (fq == 0) part[(wr * 64 + fr + ai * 128 + m * 16) * 4 + wc] = ss;
                asm volatile("" ::: "memory"); }
        asm volatile("s_waitcnt lgkmcnt(0)" ::: "memory"); __builtin_amdgcn_s_barrier(); asm volatile("" ::: "memory");
        const int t = (wr * 4 + wc) * 64 + fq * 16 + fr;
        if (t < 256) { const f32x4 p = *(const LAS f32x4*)(part + t * 4); rsp_out[(size_t)(u.pm * 256 + t) * 8 + u.pn] = (p[0] + p[1]) + (p[2] + p[3]); }
    }
    __device__ __forceinline__ void reset(pg8::Acc& acc, const pg8::Unit&, int, int, int, int) const { acc_zero(acc); }
};

struct EpiGU {
    static constexpr bool PERM = true, ZERO_RESET = false;
    const float* rsq; bf16* H; int ldh; LAS const float* rst;
    __device__ __forceinline__ void operator()(const pg8::Acc& acc, const pg8::Unit& u, int wr, int wc, int fr, int fq) const {
        const int row0 = u.pm * 256 + wr * 64 + fr, col0 = u.pn * 128 + wc * 32 + 8 * fq;
        RowScales RS; row_scales8_lds(RS, rst, u, row0);
#pragma unroll
        for (int ai = 0; ai < 2; ++ai)
#pragma unroll
            for (int m = 0; m < 4; ++m) { const size_t r = (size_t)(row0 + ai * 128 + m * 16); const float rs = RS.v[ai * 4 + m], nr = rs * NLOG2E, r2 = rs * rs;
                const f32x4 t0 = acc[ai][0][m][0] * nr, t1 = acc[ai][0][m][1] * nr;
                f32x4 h0 = acc[ai][0][m][0] * acc[ai][1][m][0] * r2, h1 = acc[ai][0][m][1] * acc[ai][1][m][1] * r2;
#pragma unroll
                for (int j = 0; j < 4; ++j) { h0[j] *= sig_pre(t0[j]); h1[j] *= sig_pre(t1[j]); }
                *(v4u*)(H + r * ldh + col0) = pack8(h0, h1); }
    }
    __device__ __forceinline__ void reset(pg8::Acc& acc, const pg8::Unit&, int, int, int, int) const { acc_zero(acc); }
};
struct EpiGUMoe {
    static constexpr bool PERM = true, ZERO_RESET = true;
    unsigned char* ACT8; MoeTiles mt;
    __device__ __forceinline__ void operator()(const pg8::Acc& acc, const pg8::Unit& u, int wr, int wc, int fr, int fq) const {
        const int e = u.aux & 255, lt = u.aux >> 8, n = mt.cnt_of(e);
        const int rl0 = wr * 64 + fr, col0 = u.pn * 128 + wc * 32 + 8 * fq;
#pragma unroll
        for (int ai = 0; ai < 2; ++ai)
#pragma unroll
            for (int m = 0; m < 4; ++m) { const int rl = rl0 + ai * 128 + m * 16, pos = lt * 256 + rl; const float sg = (1.0f / W8_SCALE), su = pos < n ? (ACT8_SCALE / W8_SCALE) * sg : 0.f;
                const f32x4 t0 = acc[ai][0][m][0] * (NLOG2E * sg), t1 = acc[ai][0][m][1] * (NLOG2E * sg);
                f32x4 h0 = acc[ai][0][m][0] * acc[ai][1][m][0] * su, h1 = acc[ai][0][m][1] * acc[ai][1][m][1] * su;
#pragma unroll
                for (int j = 0; j < 4; ++j) { h0[j] *= sig_pre(t0[j]); h1[j] *= sig_pre(t1[j]); }
                v2u w; w.x = pack4_fp8(h0[0], h0[1], h0[2], h0[3]); w.y = pack4_fp8(h1[0], h1[1], h1[2], h1[3]);
                *(v2u*)(ACT8 + (size_t)(u.pm * 256 + rl) * DFFE + col0) = w; }
    }
    __device__ __forceinline__ void reset(pg8::Acc& acc, const pg8::Unit&, int, int, int, int) const { acc_zero(acc); }
};
struct EpiDnMoe {
    static constexpr bool PERM = true, ZERO_RESET = true;
    bf16* YP;
    __device__ __forceinline__ void operator()(const pg8::Acc& acc, const pg8::Unit& u, int wr, int wc, int fr, int fq) const {
        const int row0 = u.pm * 256 + wr * 64 + fr, col0 = u.pn * 256 + wc * 32 + 8 * fq; bf16* yp = YP + (size_t)(u.aux >> 8) * ((size_t)MOE_MAXT * 256 * D);
        const float sc = 1.0f / (W8_SCALE * ACT8_SCALE);
#pragma unroll
        for (int ai = 0; ai < 2; ++ai)
#pragma unroll
            for (int m = 0; m < 4; ++m) { const size_t r = (size_t)(row0 + ai * 128 + m * 16);
#pragma unroll
                for (int bj = 0; bj < 2; ++bj) *(v4u*)(yp + r * D + col0 + bj * 128) = pack8(acc[ai][bj][m][0] * sc, acc[ai][bj][m][1] * sc); }
    }
    __device__ __forceinline__ void reset(pg8::Acc& acc, const pg8::Unit&, int, int, int, int) const { acc_zero(acc); }
};
constexpr size_t MiB = 1u << 20;
constexpr size_t WS_CTL = 0, CTL_ZERO_BYTES = 1 * MiB;
constexpr size_t WS_SMALL = 1 * MiB;
constexpr size_t WS_LBV = WS_SMALL;
constexpr size_t WS_LIST = WS_SMALL + 64 * 1024;
constexpr size_t WS_RSL = WS_LIST + 256 * 1024;
constexpr size_t WS_TSLOT = WS_RSL + 256 * 1024;
constexpr size_t WS_TW = WS_TSLOT + 64 * 1024;
constexpr size_t WS_DEC = 2 * MiB;
constexpr size_t WS_ER = 3 * MiB;
constexpr size_t WS_RSP = 4 * MiB;
constexpr size_t WS_WIN = 8 * MiB;
constexpr size_t WS_WPA = WS_WIN + 92 * MiB;
constexpr size_t WS_WPB = WS_WPA + 8 * MiB;
constexpr size_t WS_WOUT = WS_WPB + 8 * MiB;
constexpr size_t WS_WGU0 = WS_WOUT + 16 * MiB;
constexpr size_t WS_WD0 = WS_WGU0 + 44 * MiB;
constexpr size_t WS_WGUE = WS_WD0 + 22 * MiB;
constexpr size_t WS_WDE = WS_WGUE + 224 * MiB;
constexpr size_t WS_WIN8 = WS_WDE + 112 * MiB;
constexpr size_t WS_XB8 = WS_WIN8 + 16 * MiB;
constexpr size_t WS_XA = WS_XB8 + 16 * MiB;
constexpr size_t WS_XB = WS_XA + 64 * MiB;
constexpr size_t WS_MIX = WS_XB + 32 * MiB;
constexpr size_t WS_Q = WS_MIX;
constexpr size_t WS_K = WS_Q + 24 * MiB;
constexpr size_t WS_G = WS_K + 24 * MiB;
constexpr size_t WS_V = WS_G + 48 * MiB;
constexpr size_t WS_SG = WS_V + 32 * MiB;
constexpr size_t WS_M = WS_SG + 32 * MiB;
constexpr size_t WS_Y = WS_M + 64 * MiB;
constexpr size_t WS_MG = WS_Y + 32 * MiB;
constexpr size_t WS_LS = WS_MG + 32 * MiB;
constexpr size_t WS_SP = WS_LS + 128 * MiB;
constexpr size_t WS_MIX_END = WS_SP + 64 * MiB;
constexpr size_t WS_H = WS_MIX;
constexpr size_t WS_ACT = WS_MIX;
constexpr size_t WS_X8 = WS_ACT + 128 * MiB;
constexpr size_t WS_YP = WS_X8 + 16 * MiB;
static_assert(WS_YP + 144 * MiB <= WS_MIX_END, "MoE overlay fits the mixer region");
constexpr size_t WS_END = WS_MIX_END;
constexpr int CW_BAR = 4096;
constexpr int CW_CNT = 16384;

constexpr int RING_OFF = 0, RING_BYTES = 131072;
constexpr int LDSCTL_OFF = RING_BYTES, MISC_OFF = LDSCTL_OFF + 320;
constexpr int PART_OFF = RING_BYTES + 1024;
constexpr int LDS_BYTES = 147456;
constexpr int NWAVES = 8;

#define XB_TMO      128
#define XB_XCNT(j)  (256  + 64 * (j))
#define XB_XSUB(j)  (1280 + 64 * (j))
#define XB_XGEN(j)  (2304 + 64 * (j))
#define XB_TOP      3328
#define XB_TOPGEN   3392
#define XCD_BAR_WORDS 3456
#define XB_SPIN_CAP (1u << 18)

__device__ __forceinline__ unsigned xb_ld(unsigned* p)              { return __hip_atomic_load(p, __ATOMIC_RELAXED, __HIP_MEMORY_SCOPE_AGENT); }
__device__ __forceinline__ unsigned xb_add(unsigned* p, unsigned v) { return __hip_atomic_fetch_add(p, v, __ATOMIC_RELAXED, __HIP_MEMORY_SCOPE_AGENT); }
__device__ __forceinline__ unsigned xb_xcc_id() { return (unsigned)__builtin_amdgcn_s_getreg((3 << 11) | 20) & 0xFu; }
#define XB_SPIN(cond, bar) do { unsigned _sp = 0; while (cond) { __builtin_amdgcn_s_sleep(1); \
    if ((++_sp & 255u) == 0u) { if (xb_ld(&(bar)[XB_TMO])) break; if (_sp > XB_SPIN_CAP) { atomicAdd(&(bar)[XB_TMO], 1u); break; } } } } while (0)

struct XcdBarrier {
    unsigned* bar; unsigned x;
    volatile LAS unsigned* st;
};
__device__ __forceinline__ XcdBarrier xcd_barrier_post(unsigned* bar, volatile LAS unsigned* st) {
    XcdBarrier b; b.bar = bar; b.x = xb_xcc_id(); b.st = st;
    if (threadIdx.x == 0) (void)xb_add(&bar[XB_XCNT(b.x)], 1u);
    return b;
}
__device__ __forceinline__ void xcd_barrier_complete(unsigned* bar, unsigned x, unsigned& nloc, unsigned& nx) {
    const unsigned G = gridDim.x * gridDim.y * gridDim.z;
    unsigned sum, cnt, mine, sp = 0u;
    for (;;) {
        sum = 0u; cnt = 0u; mine = 0u;
#pragma unroll
        for (unsigned j = 0; j < 16; ++j) { const unsigned c = xb_ld(&bar[XB_XCNT(j)]); sum += c; cnt += (c > 0u) ? 1u : 0u; mine = (j == x) ? c : mine; }
        if (sum == G) break;
        __builtin_amdgcn_s_sleep(1);
        if ((++sp & 255u) == 0u) { if (xb_ld(&bar[XB_TMO])) break; if (sp > XB_SPIN_CAP) { atomicAdd(&bar[XB_TMO], 1u); break; } }
    }
    nloc = mine > 0u ? mine : 1u; nx = cnt > 0u ? cnt : 1u;
}
__device__ __forceinline__ void xcd_barrier(const XcdBarrier& b) {
    asm volatile("s_waitcnt vmcnt(0)" ::: "memory");
    __syncthreads();
    if (threadIdx.x == 0) {
        unsigned* bar = b.bar; asm volatile("" : "+s"(bar));
        __builtin_amdgcn_s_waitcnt(0);
        unsigned nloc = b.st[0], nx = b.st[1];
        if (nloc == 0u) { xcd_barrier_complete(bar, b.x, nloc, nx); b.st[0] = nloc; b.st[1] = nx; }
        const unsigned old = xb_add(&bar[XB_XSUB(b.x)], 1u);
        const unsigned gen = old / nloc;
        if (old + 1u == (gen + 1u) * nloc) {
            __builtin_amdgcn_fence(__ATOMIC_RELEASE, "agent");
            asm volatile("s_waitcnt vmcnt(0)" ::: "memory");
            const unsigned og = xb_add(&bar[XB_TOP], 1u);
            const unsigned tg = og / nx;
            if (og + 1u == (tg + 1u) * nx) xb_add(&bar[XB_TOPGEN], 1u);
            else XB_SPIN(xb_ld(&bar[XB_TOPGEN]) == tg, bar);
            __builtin_amdgcn_fence(__ATOMIC_ACQUIRE, "agent");
            xb_add(&bar[XB_XGEN(b.x)], 1u);
            asm volatile("s_waitcnt vmcnt(0)" ::: "memory");
        } else {
            XB_SPIN(xb_ld(&bar[XB_XGEN(b.x)]) == gen, bar);
            __builtin_amdgcn_fence(__ATOMIC_ACQUIRE, "agent");
            asm volatile("s_waitcnt vmcnt(0)" ::: "memory");
        }
    }
    __syncthreads();
}

struct ConvRegs { f32x4 w[8]; };
__device__ __forceinline__ void conv_load(ConvRegs& r, const float* W, int ldw, int c0, const float* kscale, int kb, int lane) {
    const int n4 = lane & 7, kg = lane >> 3; const float* src = W + (size_t)(64 * kb + 8 * kg) * ldw + c0 + 4 * n4;
#pragma unroll
    for (int i = 0; i < 8; ++i) r.w[i] = __builtin_nontemporal_load((const f32x4*)(src + (size_t)i * ldw));
    if (kscale) { const f32x4 s0 = *(const f32x4*)(kscale + 64 * kb + 8 * kg), s1 = *(const f32x4*)(kscale + 64 * kb + 8 * kg + 4);
#pragma unroll
        for (int i = 0; i < 4; ++i) { r.w[i] *= s0[i]; r.w[4 + i] *= s1[i]; } }
}
__device__ __forceinline__ void conv_store(const ConvRegs& r, int K, bf16* WT, int drow0, int kb, int lane) {
    const int n4 = lane & 7, kg = lane >> 3; bf16* dst = WT + (size_t)(drow0 + 4 * n4) * K + 64 * kb + 8 * kg;
#pragma unroll
    for (int j = 0; j < 4; ++j) { v4u o; o.x = cvt_pk_bf16(r.w[0][j], r.w[1][j]); o.y = cvt_pk_bf16(r.w[2][j], r.w[3][j]); o.z = cvt_pk_bf16(r.w[4][j], r.w[5][j]); o.w = cvt_pk_bf16(r.w[6][j], r.w[7][j]);
        *(v4u*)(dst + (size_t)j * K) = o; }
}
struct ConvJob { const float* W; const float* kscale; bf16* WT; int ldw, K, c0, drow0, kb; };
__device__ __forceinline__ unsigned pk4f8(float a, float b, float c, float d) { int w = 0; w = __builtin_amdgcn_cvt_pk_fp8_f32(a, b, w, false); w = __builtin_amdgcn_cvt_pk_fp8_f32(c, d, w, true); return (unsigned)w; }
__device__ __forceinline__ int gu_row(int c0, int isup) { return 256 * (c0 >> 7) + 128 * isup + (c0 & 127); }
struct Conv8Regs { f32x4 w[16]; };
__device__ __forceinline__ void conv8_load(Conv8Regs& r, const float* W, int ldw, int c0, int kb, int lane) {
    const int n4 = lane & 7, kg = lane >> 3; const float* src = W + (size_t)(128 * kb + 16 * kg) * ldw + c0 + 4 * n4;
#pragma unroll
    for (int i = 0; i < 16; ++i) r.w[i] = __builtin_nontemporal_load((const f32x4*)(src + (size_t)i * ldw));
}
__device__ __forceinline__ void conv8_store(const Conv8Regs& r, int K, const float* kscale, unsigned char* WT, int drow0, int kb, int lane) {
    const int n4 = lane & 7, kg = lane >> 3;
    float sc[16];
#pragma unroll
    for (int q = 0; q < 4; ++q) { f32x4 s4 = (f32x4){64.f, 64.f, 64.f, 64.f}; if (kscale) s4 = *(const f32x4*)(kscale + 128 * kb + 16 * kg + 4 * q) * 64.f; sc[4 * q] = s4[0]; sc[4 * q + 1] = s4[1]; sc[4 * q + 2] = s4[2]; sc[4 * q + 3] = s4[3]; }
    unsigned char* dst = WT + (size_t)(drow0 + 4 * n4) * K + 128 * kb + 16 * kg;
#pragma unroll
    for (int j = 0; j < 4; ++j) { v4u o;
        o.x = pk4f8(r.w[0][j] * sc[0], r.w[1][j] * sc[1], r.w[2][j] * sc[2], r.w[3][j] * sc[3]); o.y = pk4f8(r.w[4][j] * sc[4], r.w[5][j] * sc[5], r.w[6][j] * sc[6], r.w[7][j] * sc[7]);
        o.z = pk4f8(r.w[8][j] * sc[8], r.w[9][j] * sc[9], r.w[10][j] * sc[10], r.w[11][j] * sc[11]); o.w = pk4f8(r.w[12][j] * sc[12], r.w[13][j] * sc[13], r.w[14][j] * sc[14], r.w[15][j] * sc[15]);
        *(v4u*)(dst + (size_t)j * K) = o; }
}
struct Conv8Job { const float* W; const float* kscale; unsigned char* WT; int ldw, K, c0, drow0, kb; };
constexpr int I8_MG = 16 * 224, I8_MU = I8_MG, I8_MD = 56 * 64, I8_EXP = I8_MG + I8_MU + I8_MD, I8_ALL = NE * I8_EXP;
constexpr int I8_WIN = 2 * 16 * 128, I8_TOT = I8_ALL + I8_WIN;
struct Conv8Src { const float *wg, *wu, *wd, *fw, *win, *mw; };
__device__ __forceinline__ void conv8_decode(int it, const Conv8Src& c, unsigned char* ws, Conv8Job& j) {
    const float* wg = c.wg; const float* wu = c.wu; const float* wd = c.wd; const float* fw = c.fw;
    if (it >= I8_ALL) { const int r = it - I8_ALL, l = r >> 11, rr = r & 2047; j.kb = rr >> 7; const int nb = rr & 127;
        j.W = c.win + (size_t)l * D * DIN_SRC; j.ldw = DIN_SRC; j.K = D; j.c0 = 7184 + 32 * nb; j.kscale = c.mw + l * D; j.WT = ws + WS_WIN8 + (size_t)l * 4096 * D; j.drow0 = 32 * nb; return; }
    const int e = it / I8_EXP; int r = it - e * I8_EXP; unsigned char* wgu = ws + WS_WGUE + (size_t)e * 2 * DFFE * D;
    if (r < I8_MG) { j.kb = r / 224; const int nb = r % 224; j.W = wg + (size_t)e * D * DFFE; j.ldw = DFFE; j.K = D; j.c0 = 32 * nb; j.kscale = fw; j.WT = wgu; j.drow0 = gu_row(32 * nb, 0); return; } r -= I8_MG;
    if (r < I8_MU) { j.kb = r / 224; const int nb = r % 224; j.W = wu + (size_t)e * D * DFFE; j.ldw = DFFE; j.K = D; j.c0 = 32 * nb; j.kscale = fw; j.WT = wgu; j.drow0 = gu_row(32 * nb, 1); return; } r -= I8_MU;
    { j.kb = r / 64; const int nb = r % 64; j.W = wd + (size_t)e * DFFE * D; j.ldw = D; j.K = DFFE; j.c0 = 32 * nb; j.kscale = nullptr; j.WT = ws + WS_WDE + (size_t)e * D * DFFE; j.drow0 = 32 * nb; return; }
}
__device__ __forceinline__ void conv8_range(int lo, int hi, int w, int nw, const Conv8Src& c, unsigned char* ws, int lane) {
    Conv8Job j0, j1; Conv8Regs r0, r1; int i0 = lo + w, i1 = lo + w + nw;
    if (i0 < hi) { conv8_decode(i0, c, ws, j0); conv8_load(r0, j0.W, j0.ldw, j0.c0, j0.kb, lane); }
    if (i1 < hi) { conv8_decode(i1, c, ws, j1); conv8_load(r1, j1.W, j1.ldw, j1.c0, j1.kb, lane); }
    while (i0 < hi) {
        conv8_store(r0, j0.K, j0.kscale, j0.WT, j0.drow0, j0.kb, lane);
        i0 += 2 * nw; if (i0 < hi) { conv8_decode(i0, c, ws, j0); conv8_load(r0, j0.W, j0.ldw, j0.c0, j0.kb, lane); }
        if (i1 < hi) { conv8_store(r1, j1.K, j1.kscale, j1.WT, j1.drow0, j1.kb, lane);
            i1 += 2 * nw; if (i1 < hi) { conv8_decode(i1, c, ws, j1); conv8_load(r1, j1.W, j1.ldw, j1.c0, j1.kb, lane); } }
    }
}
struct P0Args {
    const float *x, *mix_norm_w, *w_in, *lbl, *gk_up_w, *w_proj_a, *w_proj_b, *w_out, *ffn_norm_w, *dense_w_gate, *dense_w_up, *dense_w_down, *moe_w_gate, *moe_w_up, *moe_w_down;
    unsigned char* ws;
};
__device__ __forceinline__ void p0_prologue(const P0Args& a, LAS unsigned char* lds, int vcu, int G, int wave, int lane) {
    const int gw = vcu * NWAVES + wave, NGW = G * NWAVES;
    unsigned char* ws = a.ws;
    constexpr int I_INA = 32 * 224, I_PA = 16 * 64, I_PB = 16 * 64, I_WO = 32 * 64;
    constexpr int I_LAYER = I_INA + I_PA + I_PB + I_WO;
    constexpr int I_DG = 32 * 176, I_DU = I_DG, I_DD = 88 * 64;
    constexpr int NITEMS = 2 * I_LAYER + I_DG + I_DU + I_DD;
    auto decode = [&](int it, ConvJob& j) {
        int r = it; j.kscale = nullptr;
        if (r < 2 * I_LAYER) {
            const int l = r / I_LAYER; r -= l * I_LAYER;
            const float* win = a.w_in + (size_t)l * D * DIN_SRC; bf16* wint = (bf16*)(ws + WS_WIN) + (size_t)l * NIN * D; const float* mw = a.mix_norm_w + l * D;
            if (r < I_INA) { j.kb = r / 224; const int nb = r % 224; j.W = win; j.ldw = DIN_SRC; j.K = D; j.c0 = 32 * nb; j.kscale = mw; j.WT = wint; j.drow0 = 32 * nb; return; } r -= I_INA;
            if (r < I_PA) { j.kb = r / 64; const int nb = r % 64; j.W = a.w_proj_a + (size_t)l * 1024 * D; j.ldw = D; j.K = 1024; j.c0 = 32 * nb; j.WT = (bf16*)(ws + WS_WPA) + (size_t)l * D * 1024; j.drow0 = 32 * nb; return; } r -= I_PA;
            if (r < I_PB) { j.kb = r / 64; const int nb = r % 64; j.W = a.w_proj_b + (size_t)l * 1024 * D; j.ldw = D; j.K = 1024; j.c0 = 32 * nb; j.WT = (bf16*)(ws + WS_WPB) + (size_t)l * D * 1024; j.drow0 = 32 * nb; return; } r -= I_PB;
            { j.kb = r / 64; const int nb = r % 64; j.W = a.w_out + (size_t)l * D * D; j.ldw = D; j.K = D; j.c0 = 32 * nb; j.WT = (bf16*)(ws + WS_WOUT) + (size_t)l * D * D; j.drow0 = 32 * nb; return; }
        }
        r -= 2 * I_LAYER;
        if (r < I_DG) { j.kb = r / 176; const int nb = r % 176; j.W = a.dense_w_gate; j.ldw = DFF; j.K = D; j.c0 = 32 * nb; j.kscale = a.ffn_norm_w; j.WT = (bf16*)(ws + WS_WGU0); j.drow0 = gu_row(32 * nb, 0); return; } r -= I_DG;
        if (r < I_DU) { j.kb = r / 176; const int nb = r % 176; j.W = a.dense_w_up; j.ldw = DFF; j.K = D; j.c0 = 32 * nb; j.kscale = a.ffn_norm_w; j.WT = (bf16*)(ws + WS_WGU0); j.drow0 = gu_row(32 * nb, 1); return; } r -= I_DU;
        { j.kb = r / 64; const int nb = r % 64; j.W = a.dense_w_down; j.ldw = D; j.K = DFF; j.c0 = 32 * nb; j.WT = (bf16*)(ws + WS_WD0); j.drow0 = 32 * nb; return; }
    };
    { ConvJob j[4]; ConvRegs r[4]; int ii[4];
#pragma unroll
      for (int q = 0; q < 4; ++q) { ii[q] = gw + q * NGW; if (ii[q] < NITEMS) { decode(ii[q], j[q]); conv_load(r[q], j[q].W, j[q].ldw, j[q].c0, j[q].kscale, j[q].kb, lane); } }
      while (ii[0] < NITEMS) {
#pragma unroll
          for (int q = 0; q < 4; ++q) { if (ii[q] < NITEMS) { conv_store(r[q], j[q].K, j[q].WT, j[q].drow0, j[q].kb, lane);
              ii[q] += 4 * NGW; if (ii[q] < NITEMS) { decode(ii[q], j[q]); conv_load(r[q], j[q].W, j[q].ldw, j[q].c0, j[q].kscale, j[q].kb, lane); } } }
      } }
    const int gt = (vcu * NWAVES + wave) * 64 + lane, NGT = NGW * 64;
    for (int idx = gt; idx < 2 * 512 * 256; idx += NGT) {
        const int l = idx / (512 * 256), rem = idx % (512 * 256), kq = rem / 512, j = rem % 512;
        const float* win = a.w_in + (size_t)l * D * DIN_SRC; const float* up = a.gk_up_w + (size_t)l * 16 * 512; const float* mw = a.mix_norm_w + l * D;
        float uj[16];
#pragma unroll
        for (int rr = 0; rr < 16; ++rr) uj[rr] = up[rr * 512 + j];
        float o[8];
#pragma unroll
        for (int kk = 0; kk < 8; ++kk) { const int k = 8 * kq + kk; const f32x4* wr = (const f32x4*)(win + (size_t)k * DIN_SRC + 7168); float s = 0.f;
#pragma unroll
            for (int q = 0; q < 4; ++q) { const f32x4 w = wr[q]; s += w[0] * uj[4 * q] + w[1] * uj[4 * q + 1] + w[2] * uj[4 * q + 2] + w[3] * uj[4 * q + 3]; }
            o[kk] = s * mw[k]; }
        v4u w; w.x = cvt_pk_bf16(o[0], o[1]); w.y = cvt_pk_bf16(o[2], o[3]); w.z = cvt_pk_bf16(o[4], o[5]); w.w = cvt_pk_bf16(o[6], o[7]);
        *(v4u*)((bf16*)(ws + WS_WIN) + (size_t)l * NIN * D + (size_t)(7168 + j) * D + 8 * kq) = w;
    }
    for (int idx = gt; idx < 2048; idx += NGT) { const int l = idx >> 10, c = idx & 1023; float v = 0.f;
        if (l == 1) { const float l0 = a.lbl[c], l1 = a.lbl[1024 + c]; v = 1.f / (1.f + __expf(l0 - l1)); }
        ((float*)(ws + WS_LBV))[idx] = v; }
    float* rsp0 = (float*)(ws + WS_RSP);
    for (int m = gw; m < T; m += NGW) {
        const f32x4* xr = (const f32x4*)(a.x + (size_t)m * D) + lane; f32x4 v[8]; float s = 0.f;
#pragma unroll
        for (int j = 0; j < 8; ++j) { v[j] = xr[64 * j]; s += (v[j][0] * v[j][0] + v[j][1] * v[j][1]) + (v[j][2] * v[j][2] + v[j][3] * v[j][3]); }
        s = wave_sum(s);
        v2u* o8 = (v2u*)((bf16*)(ws + WS_XB) + (size_t)m * D) + lane;
#pragma unroll
        for (int j = 0; j < 8; ++j) { v2u w; w.x = cvt_pk_bf16(v[j][0], v[j][1]); w.y = cvt_pk_bf16(v[j][2], v[j][3]); o8[64 * j] = w; }
        { unsigned* o4 = (unsigned*)(ws + WS_XB8 + (size_t)m * D) + lane;
#pragma unroll
          for (int j = 0; j < 8; ++j) o4[64 * j] = pack4_fp8(v[j][0] * X8_SCALE, v[j][1] * X8_SCALE, v[j][2] * X8_SCALE, v[j][3] * X8_SCALE); }
        if (lane == 0) { *(f32x4*)(rsp0 + (size_t)m * 8) = (f32x4){s, 0.f, 0.f, 0.f}; *(f32x4*)(rsp0 + (size_t)m * 8 + 4) = (f32x4){0.f, 0.f, 0.f, 0.f}; }
    }
}

typedef short v4i16_t __attribute__((ext_vector_type(4)));
__device__ __forceinline__ s16x4 tr_read(const LAS unsigned char* p) { return __builtin_bit_cast(s16x4, __builtin_amdgcn_ds_read_tr16_b64_v4i16((LAS v4i16_t*)p)); }
__device__ __forceinline__ bf16x8 tr_frag(const LAS unsigned char* img, int stride, int f0, int kk, int lane) {
    const int l16 = lane & 15, q = lane >> 4;
    const LAS unsigned char* p = img + (32 * kk + 8 * q + (l16 >> 2)) * stride + (f0 + 4 * (l16 & 3)) * 2;
    const s16x4 lo = tr_read(p), hi = tr_read(p + 4 * stride);
    bf16x8 r; r[0] = lo[0]; r[1] = lo[1]; r[2] = lo[2]; r[3] = lo[3]; r[4] = hi[0]; r[5] = hi[1]; r[6] = hi[2]; r[7] = hi[3]; return r;
}
__device__ __forceinline__ int head_ebase(int hh) { return hh < 8 ? hh * 16384 : 131072 + (hh - 8) * 32768; }
__device__ __forceinline__ int head_vcol(int hh) { return hh < 8 ? hh * 128 : 1024 + (hh - 8) * 256; }

struct LaPtrs { bf16 *Q, *Kb, *V, *SG, *Y, *SP, *LS; float *Gf, *DEC, *ER; const float *nwa, *nwb; };

struct ARegs { f32x4 g[4]; v2u q[4], k[4]; v4u v[4]; };
__device__ __forceinline__ void la_a_load(ARegs& R, const LaPtrs& P, int hh, int c, int tid) {
    const int dv = hh < 8 ? 128 : 256, qcol = hh * 128, vcol = head_vcol(hh), t0 = c * CH, dq = tid & 31, tg = tid >> 5, d0 = 4 * dq;
    const float* gp = P.Gf + (size_t)(t0 + 4 * tg) * QK_LD + qcol + d0;
#pragma unroll
    for (int s = 0; s < 4; ++s) { R.g[s] = *(const f32x4*)(gp + (size_t)s * QK_LD); const size_t idx = (size_t)(t0 + 4 * tg + s) * QK_LD + qcol + d0; R.q[s] = *(const v2u*)(P.Q + idx); R.k[s] = *(const v2u*)(P.Kb + idx); }
    const int cpr = dv / 8;
#pragma unroll
    for (int i = 0; i < 4; ++i) { if (i < dv / 64) { const int ch = tid + 512 * i, t = ch / cpr, cc = ch % cpr; R.v[i] = *(const v4u*)(P.V + (size_t)(t0 + t) * V_LD + vcol + cc * 8); } }
}
__device__ __forceinline__ void la_a_unit(const LaPtrs& P, LAS unsigned char* lds, int hh, int c, int tid, int wave, int lane, ARegs& R, bool has_next, int nhh, int nc) {
    const int dv = hh < 8 ? 128 : 256, qcol = hh * 128, t0 = c * CH;
    LAS float* tot = (LAS float*)lds;
    LAS float* elv = (LAS float*)(lds + 8192);
    LAS unsigned char* kimg = lds + 8192 + 512;
    LAS unsigned char* vimg = kimg + 64 * 288;
    const int vstride = (dv + 16) * 2;
    const int dq = tid & 31, tg = tid >> 5, d0 = 4 * dq;
    f32x4 cum[4];
    { f32x4 run = (f32x4){0.f, 0.f, 0.f, 0.f};
#pragma unroll
      for (int s = 0; s < 4; ++s) { run += R.g[s]; cum[s] = run; }
      *(LAS f32x4*)(tot + tg * 128 + d0) = run; }
    v2u qraw[4], kraw[4];
#pragma unroll
    for (int s = 0; s < 4; ++s) { qraw[s] = R.q[s]; kraw[s] = R.k[s]; }
    { const int cpr = dv / 8;
#pragma unroll
      for (int i = 0; i < 4; ++i) { if (i < dv / 64) { const int ch = tid + 512 * i, t = ch / cpr, cc = ch % cpr; *(LAS v4u*)(vimg + t * vstride + cc * 16) = R.v[i]; } } }
    if (has_next) la_a_load(R, P, nhh, nc, tid);
    __syncthreads();
    f32x4 off = (f32x4){0.f, 0.f, 0.f, 0.f}, cref = off, clast = off;
#pragma unroll
    for (int g = 0; g < 16; ++g) { const f32x4 tv = *(const LAS f32x4*)(tot + g * 128 + d0); if (g < tg) off += tv; if (g < 8) cref += tv; clast += tv; }
    if (tg == 0) { f32x4 e1, e2, e3;
#pragma unroll
        for (int j = 0; j < 4; ++j) { e1[j] = fast_exp(clast[j] - cref[j]); e2[j] = fast_exp(clast[j]); e3[j] = fast_exp(cref[j]); }
        *(LAS f32x4*)(elv + d0) = e1; *(f32x4*)(P.DEC + (size_t)(c * NHEADS + hh) * 128 + d0) = e2; *(f32x4*)(P.ER + (size_t)(c * NHEADS + hh) * 128 + d0) = e3; }
#pragma unroll
    for (int s = 0; s < 4; ++s) { const int t = 4 * tg + s; f32x4 eq, ek;
#pragma unroll
        for (int j = 0; j < 4; ++j) { const float x = clampf(cum[s][j] + off[j] - cref[j], -85.f, 85.f); eq[j] = fast_exp(x); ek[j] = fast_exp(-x); }
        v2u qo, ko; qo.x = cvt_pk_bf16(bflo(qraw[s].x) * eq[0], bfhi(qraw[s].x) * eq[1]); qo.y = cvt_pk_bf16(bflo(qraw[s].y) * eq[2], bfhi(qraw[s].y) * eq[3]);
        ko.x = cvt_pk_bf16(bflo(kraw[s].x) * ek[0], bfhi(kraw[s].x) * ek[1]); ko.y = cvt_pk_bf16(bflo(kraw[s].y) * ek[2], bfhi(kraw[s].y) * ek[3]);
        const size_t idx = (size_t)(t0 + t) * QK_LD + qcol + d0;
        *(v2u*)(P.Q + idx) = qo; *(v2u*)(P.Kb + idx) = ko; *(LAS v2u*)(kimg + t * 288 + d0 * 2) = ko; }
    __syncthreads();
    const int ntl = dv / 128;
    const int l16 = lane & 15, q4 = lane >> 4;
    bf16* LSc = P.LS + (size_t)c * STATE_E + head_ebase(hh);
    for (int ti = 0; ti < ntl; ++ti) {
        const int n0 = 16 * (wave * ntl + ti);
        const bf16x8 b0 = tr_frag(vimg, vstride, n0, 0, lane), b1 = tr_frag(vimg, vstride, n0, 1, lane);
#pragma unroll
        for (int dt = 0; dt < 8; ++dt) {
            const bf16x8 a0 = tr_frag(kimg, 288, 16 * dt, 0, lane), a1 = tr_frag(kimg, 288, 16 * dt, 1, lane);
            f32x4 acc = (f32x4){0.f, 0.f, 0.f, 0.f};
            acc = __builtin_amdgcn_mfma_f32_16x16x32_bf16(a0, b0, acc, 0, 0, 0);
            acc = __builtin_amdgcn_mfma_f32_16x16x32_bf16(a1, b1, acc, 0, 0, 0);
            const f32x4 el = *(const LAS f32x4*)(elv + 16 * dt + 4 * q4);
            { const f32x4 lv = acc * el; v2u w; w.x = cvt_pk_bf16(lv[0], lv[1]); w.y = cvt_pk_bf16(lv[2], lv[3]); *(v2u*)(LSc + (size_t)(n0 + l16) * 128 + 16 * dt + 4 * q4) = w; }
        }
    }
    __syncthreads();
}

__device__ __forceinline__ void la_b_scan(const LaPtrs& P, LAS unsigned char* lds, int bx, int G, int tid) {
    LAS float* decs = (LAS float*)lds; LAS float* ers = (LAS float*)(lds + 65536);
    for (int p0 = bx * 256; p0 < STATE_E / 4; p0 += G * 256) {
        const int e0 = 4 * p0; const int hh = e0 < 131072 ? (e0 >> 14) : 8 + ((e0 - 131072) >> 15);
        for (int i = tid; i < 4096; i += 512) { const int c = i >> 5, q = i & 31;
            *(LAS f32x4*)(decs + c * 128 + 4 * q) = *(const f32x4*)(P.DEC + (size_t)(c * NHEADS + hh) * 128 + 4 * q);
            *(LAS f32x4*)(ers + c * 128 + 4 * q) = *(const f32x4*)(P.ER + (size_t)(c * NHEADS + hh) * 128 + 4 * q); }
        __syncthreads();
        {
            const int e = e0 + 2 * tid, d = e & 127;
            f32x2_t s = (f32x2_t){0.f, 0.f};
            const bf16* lsp = P.LS + e; bf16* spp = P.SP + e;
            unsigned cur[32], nxt[32];
#pragma unroll
            for (int j = 0; j < 32; ++j) cur[j] = __builtin_nontemporal_load((const unsigned*)(lsp + (size_t)j * STATE_E));
            for (int c0 = 0; c0 < NCH; c0 += 32) {
                if (c0 + 32 < NCH) {
#pragma unroll
                    for (int j = 0; j < 32; ++j) nxt[j] = __builtin_nontemporal_load((const unsigned*)(lsp + (size_t)(c0 + 32 + j) * STATE_E)); }
#pragma unroll
                for (int j = 0; j < 32; ++j) { const int c = c0 + j;
                    const f32x2_t er = *(const LAS f32x2_t*)(ers + c * 128 + d), dc = *(const LAS f32x2_t*)(decs + c * 128 + d);
                    const f32x2_t l = (f32x2_t){bflo(cur[j]), bfhi(cur[j])};
                    const f32x2_t sp = er * s;
                    *(unsigned*)(spp + (size_t)c * STATE_E) = cvt_pk_bf16(sp[0], sp[1]);
                    s = dc * s + l; }
#pragma unroll
                for (int j = 0; j < 32; ++j) cur[j] = nxt[j];
            }
        }
        __syncthreads();
    }
}

struct CRegs { v4u q[2], k[2], v[4]; };
__device__ __forceinline__ void la_c_load(CRegs& R, const LaPtrs& P, int hh, int c, int tid) {
    const int dv = hh < 8 ? 128 : 256, qcol = hh * 128, vcol = head_vcol(hh), t0 = c * CH;
    { const int t = tid >> 3, cc = tid & 7; const bf16* qp = P.Q + (size_t)(t0 + t) * QK_LD + qcol + cc * 8; const bf16* kp = P.Kb + (size_t)(t0 + t) * QK_LD + qcol + cc * 8;
      R.q[0] = *(const v4u*)qp; R.q[1] = *(const v4u*)(qp + 64); R.k[0] = *(const v4u*)kp; R.k[1] = *(const v4u*)(kp + 64); }
    const int cpr = dv / 8;
#pragma unroll
    for (int i = 0; i < 4; ++i) { if (i < dv / 64) { const int ch = tid + 512 * i, t = ch / cpr, cc = ch % cpr; R.v[i] = *(const v4u*)(P.V + (size_t)(t0 + t) * V_LD + vcol + cc * 8); } }
}
__device__ __forceinline__ void la_c_unit(const LaPtrs& P, LAS unsigned char* lds, int hh, int c, int tid, int wave, int lane, CRegs& R, bool has_next, int nhh, int nc) {
    const int dv = hh < 8 ? 128 : 256, qcol = hh * 128, vcol = head_vcol(hh), t0 = c * CH;
    LAS unsigned char* As = lds;
    LAS float* red = (LAS float*)(lds + 9216);
    LAS unsigned char* qimg = lds + 12288;
    LAS unsigned char* kimg = qimg + 64 * 272;
    LAS unsigned char* vimg = kimg + 64 * 272;
    const int vstride = (dv + 16) * 2;
    const int l16 = lane & 15, q4 = lane >> 4;
    const int ntl = dv / 128;
    { const int t = tid >> 3, cc = tid & 7;
      *(LAS v4u*)(qimg + t * 272 + cc * 16) = R.q[0]; *(LAS v4u*)(qimg + t * 272 + 128 + cc * 16) = R.q[1]; *(LAS v4u*)(kimg + t * 272 + cc * 16) = R.k[0]; *(LAS v4u*)(kimg + t * 272 + 128 + cc * 16) = R.k[1]; }
    { const int cpr = dv / 8;
#pragma unroll
      for (int i = 0; i < 4; ++i) { if (i < dv / 64) { const int ch = tid + 512 * i, t = ch / cpr, cc = ch % cpr; *(LAS v4u*)(vimg + t * vstride + cc * 16) = R.v[i]; } } }
    const bf16* SPc = P.SP + (size_t)c * STATE_E + head_ebase(hh);
    bf16x8 as[2][4];
    v2u gt[2][4]; f32x4 nwv[2];
    const float* nw = hh < 8 ? P.nwa : P.nwb;
#pragma unroll
    for (int ti = 0; ti < 2; ++ti) { if (ti < ntl) { const int n0 = 16 * (wave * ntl + ti);
#pragma unroll
        for (int kk = 0; kk < 4; ++kk) as[ti][kk] = *(const bf16x8*)(SPc + (size_t)(n0 + l16) * 128 + 32 * kk + 8 * q4);
        nwv[ti] = *(const f32x4*)(nw + n0 + 4 * q4);
#pragma unroll
        for (int it = 0; it < 4; ++it) gt[ti][it] = *(const v2u*)(P.SG + (size_t)(t0 + 16 * it + l16) * V_LD + vcol + n0 + 4 * q4); } }
    if (has_next) la_c_load(R, P, nhh, nc, tid);
    __syncthreads();
    { const int jt = wave >> 1;
#pragma unroll
      for (int ii = 0; ii < 2; ++ii) { const int it = 2 * (wave & 1) + ii; const int j0 = 16 * jt, i0 = 16 * it;
          f32x4 acc = (f32x4){0.f, 0.f, 0.f, 0.f};
          if (jt <= it) {
#pragma unroll
              for (int kk = 0; kk < 4; ++kk) { const bf16x8 kf = *(const LAS bf16x8*)(kimg + (j0 + l16) * 272 + (32 * kk + 8 * q4) * 2), qf = *(const LAS bf16x8*)(qimg + (i0 + l16) * 272 + (32 * kk + 8 * q4) * 2);
                  acc = __builtin_amdgcn_mfma_f32_16x16x32_bf16(kf, qf, acc, 0, 0, 0); } }
          const int i = i0 + l16; f32x4 mv;
#pragma unroll
          for (int jj = 0; jj < 4; ++jj) mv[jj] = (j0 + 4 * q4 + jj <= i) ? acc[jj] : 0.f;
          v2u w; w.x = cvt_pk_bf16(mv[0], mv[1]); w.y = cvt_pk_bf16(mv[2], mv[3]);
          *(LAS v2u*)(As + i * 144 + (j0 + 4 * q4) * 2) = w; } }
    __syncthreads();
    f32x4 o[2][4];
#pragma unroll
    for (int ti = 0; ti < 2; ++ti)
#pragma unroll
        for (int it = 0; it < 4; ++it) o[ti][it] = (f32x4){0.f, 0.f, 0.f, 0.f};
#pragma unroll
    for (int it = 0; it < 4; ++it) { const int i0 = 16 * it;
        const bf16x8 bf0 = *(const LAS bf16x8*)(As + (i0 + l16) * 144 + (8 * q4) * 2), bf1 = *(const LAS bf16x8*)(As + (i0 + l16) * 144 + (32 + 8 * q4) * 2);
        bf16x8 bq[4];
#pragma unroll
        for (int kk = 0; kk < 4; ++kk) bq[kk] = *(const LAS bf16x8*)(qimg + (i0 + l16) * 272 + (32 * kk + 8 * q4) * 2);
#pragma unroll
        for (int ti = 0; ti < 2; ++ti) { if (ti < ntl) { const int n0 = 16 * (wave * ntl + ti);
            const bf16x8 av0 = tr_frag(vimg, vstride, n0, 0, lane), av1 = tr_frag(vimg, vstride, n0, 1, lane);
            f32x4 acc = (f32x4){0.f, 0.f, 0.f, 0.f};
            acc = __builtin_amdgcn_mfma_f32_16x16x32_bf16(av0, bf0, acc, 0, 0, 0);
            acc = __builtin_amdgcn_mfma_f32_16x16x32_bf16(av1, bf1, acc, 0, 0, 0);
#pragma unroll
            for (int kk = 0; kk < 4; ++kk) acc = __builtin_amdgcn_mfma_f32_16x16x32_bf16(as[ti][kk], bq[kk], acc, 0, 0, 0);
            o[ti][it] = acc; } } }
#pragma unroll
    for (int it = 0; it < 4; ++it) { float s = 0.f;
#pragma unroll
        for (int ti = 0; ti < 2; ++ti) s += (o[ti][it][0] * o[ti][it][0] + o[ti][it][1] * o[ti][it][1]) + (o[ti][it][2] * o[ti][it][2] + o[ti][it][3] * o[ti][it][3]);
        s += __shfl_xor(s, 16); s += __shfl_xor(s, 32);
        if (q4 == 0) red[(16 * it + l16) * 8 + wave] = s; }
    __syncthreads();
    const float inv_dv = 1.0f / (float)dv;
#pragma unroll
    for (int it = 0; it < 4; ++it) { const int i = 16 * it + l16;
        const f32x4 ra = *(const LAS f32x4*)(red + i * 8), rb = *(const LAS f32x4*)(red + i * 8 + 4);
        const float r = __builtin_amdgcn_rsqf(((ra[0] + ra[1]) + (ra[2] + ra[3]) + (rb[0] + rb[1]) + (rb[2] + rb[3])) * inv_dv + EPS);
#pragma unroll
        for (int ti = 0; ti < 2; ++ti) { if (ti < ntl) { const int n = 16 * (wave * ntl + ti) + 4 * q4; const size_t idx = (size_t)(t0 + i) * V_LD + vcol + n;
            const f32x4 w = nwv[ti]; const v2u g = gt[ti][it];
            v2u y; y.x = cvt_pk_bf16(o[ti][it][0] * r * w[0] * bflo(g.x), o[ti][it][1] * r * w[1] * bfhi(g.x)); y.y = cvt_pk_bf16(o[ti][it][2] * r * w[2] * bflo(g.y), o[ti][it][3] * r * w[3] * bfhi(g.y));
            *(v2u*)(P.Y + idx) = y; } } }
    __syncthreads();
}

struct MoePtrs { const bf16* XB; const float* router_w; const float* router_b; const float* fnw; unsigned* counts; int* list; unsigned char* X8; int* tslot; float* tw; };
__device__ __forceinline__ void moe_router(const MoePtrs& P, LAS unsigned char* lds, int gw, int NGW, int wave, int lane) {
    LAS unsigned* cntl = (LAS unsigned*)lds; LAS unsigned* basel = cntl + 8;
    LAS float* rw = (LAS float*)(lds + 256);
    const int tid = wave * 64 + lane;
    for (int i = tid; i < D * NE / 4; i += 512) { const int k = i >> 1, half = i & 1, L = (k >> 2) & 63, slot = (k >> 8) * 4 + (k & 3); const float g = P.fnw[k];
        *(LAS f32x4*)(rw + ((half * 32 + slot) * 64 + L) * 4) = *(const f32x4*)(P.router_w + 4 * i) * g; }
    constexpr int RK = 4;
    for (int tb0 = 0; tb0 < T; tb0 += RK * NGW) {
        if (tid < 8) cntl[tid] = 0u;
        __syncthreads();
        int e0s[RK], e1s[RK]; float w0s[RK]; unsigned r0s[RK], r1s[RK];
        v2u xall[RK][8];
#pragma unroll
        for (int kq = 0; kq < RK; ++kq) { const int t = tb0 + kq * NGW + gw; const v2u* xr = (const v2u*)(P.XB + (size_t)(t < T ? t : 0) * D) + lane;
#pragma unroll
            for (int j = 0; j < 8; ++j) xall[kq][j] = xr[64 * j]; }
#pragma unroll
        for (int kq = 0; kq < RK; ++kq) { const int t = tb0 + kq * NGW + gw; e0s[kq] = -1; e1s[kq] = -1; w0s[kq] = 0.f; r0s[kq] = 0u; r1s[kq] = 0u;
            if (t < T) {
                float ss = 0.f; float lg[NE]; f32x4 xv[8];
#pragma unroll
                for (int e = 0; e < NE; ++e) lg[e] = 0.f;
#pragma unroll
                for (int j = 0; j < 8; ++j) xv[j] = (f32x4){bflo(xall[kq][j].x), bfhi(xall[kq][j].x), bflo(xall[kq][j].y), bfhi(xall[kq][j].y)};
#pragma unroll
                for (int j = 0; j < 8; ++j) { const f32x4 x = xv[j]; ss += (x[0] * x[0] + x[1] * x[1]) + (x[2] * x[2] + x[3] * x[3]);
#pragma unroll
                    for (int i = 0; i < 4; ++i) { const float xw = x[i]; const f32x4 r0 = *(const LAS f32x4*)(rw + ((4 * j + i) * 64 + lane) * 4), r1 = *(const LAS f32x4*)(rw + ((32 + 4 * j + i) * 64 + lane) * 4);
                        lg[0] += xw * r0[0]; lg[1] += xw * r0[1]; lg[2] += xw * r0[2]; lg[3] += xw * r0[3]; lg[4] += xw * r1[0]; lg[5] += xw * r1[1]; lg[6] += xw * r1[2]; lg[7] += xw * r1[3]; } }
                ss = wave_sum(ss); const float rs = __builtin_amdgcn_rsqf(ss * (1.0f / D) + EPS);
                { unsigned* x8 = (unsigned*)(P.X8 + (size_t)t * D) + lane;
#pragma unroll
                  for (int j = 0; j < 8; ++j) x8[64 * j] = pk4f8(xv[j][0] * rs, xv[j][1] * rs, xv[j][2] * rs, xv[j][3] * rs); }
#pragma unroll
                for (int e = 0; e < NE; ++e) lg[e] = wave_sum(lg[e]) * rs + P.router_b[e];
                int e0 = 0; float l0 = lg[0];
#pragma unroll
                for (int e = 1; e < NE; ++e) if (lg[e] > l0) { l0 = lg[e]; e0 = e; }
                int e1 = -1; float l1 = -3.0e38f;
#pragma unroll
                for (int e = 0; e < NE; ++e) if (e != e0 && lg[e] > l1) { l1 = lg[e]; e1 = e; }
                e0s[kq] = e0; e1s[kq] = e1; w0s[kq] = 1.0f / (1.0f + __expf(l1 - l0));
                if (lane == 0) { r0s[kq] = __hip_atomic_fetch_add(cntl + e0, 1u, __ATOMIC_RELAXED, __HIP_MEMORY_SCOPE_WORKGROUP); r1s[kq] = __hip_atomic_fetch_add(cntl + e1, 1u, __ATOMIC_RELAXED, __HIP_MEMORY_SCOPE_WORKGROUP); }
            } }
        __syncthreads();
        if (tid < 8) basel[tid] = __hip_atomic_fetch_add(P.counts + tid, cntl[tid], RLX_AGENT);
        __syncthreads();
        if (lane == 0) {
#pragma unroll
            for (int kq = 0; kq < RK; ++kq) { const int t = tb0 + kq * NGW + gw; if (t < T) { const int e0 = e0s[kq], e1 = e1s[kq];
                const unsigned p0 = basel[e0] + r0s[kq], p1 = basel[e1] + r1s[kq];
                if (p0 < (unsigned)MOE_CAP) P.list[e0 * MOE_CAP + p0] = t;
                if (p1 < (unsigned)MOE_CAP) P.list[e1 * MOE_CAP + p1] = t;
                P.tslot[2 * t] = e0 * MOE_CAP + (int)p0; P.tslot[2 * t + 1] = e1 * MOE_CAP + (int)p1; P.tw[2 * t] = w0s[kq]; P.tw[2 * t + 1] = 1.0f - w0s[kq]; } } }
        __syncthreads();
    }
}
__device__ __forceinline__ void final_phase(const bf16* XB, const bf16* YP, const int* tslot, const float* tw, const MoeTiles& mt, const float* fw, float* out, int gw, int NGW, int lane) {
    for (int t = gw; t < T; t += NGW) {
        const int s0 = tslot[2 * t], s1 = tslot[2 * t + 1]; const float w0 = tw[2 * t], w1 = tw[2 * t + 1];
        const int e0 = s0 / MOE_CAP, p0 = s0 % MOE_CAP, e1 = s1 / MOE_CAP, p1 = s1 % MOE_CAP;
        const size_t r0 = (size_t)mt.tb_of(e0) * 256 + p0, r1 = (size_t)mt.tb_of(e1) * 256 + p1;
        const v2u* xr = (const v2u*)(XB + (size_t)t * D) + lane; const v2u* y0 = (const v2u*)(YP + r0 * D) + lane; const v2u* y1 = (const v2u*)(YP + r1 * D) + lane; const size_t hb = (size_t)MOE_MAXT * 256 * D / 4;
        f32x4 v[8]; float ss = 0.f;
#pragma unroll
        for (int j = 0; j < 8; ++j) { const v2u xw = xr[64 * j]; const f32x4 x = (f32x4){bflo(xw.x), bfhi(xw.x), bflo(xw.y), bfhi(xw.y)}; const v2u a = y0[64 * j], b = y1[64 * j], a2 = y0[hb + 64 * j], b2 = y1[hb + 64 * j];
            v[j][0] = x[0] + w0 * (bflo(a.x) + bflo(a2.x)) + w1 * (bflo(b.x) + bflo(b2.x)); v[j][1] = x[1] + w0 * (bfhi(a.x) + bfhi(a2.x)) + w1 * (bfhi(b.x) + bfhi(b2.x));
            v[j][2] = x[2] + w0 * (bflo(a.y) + bflo(a2.y)) + w1 * (bflo(b.y) + bflo(b2.y)); v[j][3] = x[3] + w0 * (bfhi(a.y) + bfhi(a2.y)) + w1 * (bfhi(b.y) + bfhi(b2.y));
            ss += (v[j][0] * v[j][0] + v[j][1] * v[j][1]) + (v[j][2] * v[j][2] + v[j][3] * v[j][3]); }
        ss = wave_sum(ss); const float rs = __builtin_amdgcn_rsqf(ss * (1.0f / D) + EPS);
        f32x4* orow = (f32x4*)(out + (size_t)t * D) + lane; const f32x4* fwv = (const f32x4*)fw + lane;
#pragma unroll
        for (int j = 0; j < 8; ++j) orow[64 * j] = v[j] * rs * fwv[64 * j];
    }
}
#ifndef PHASE_MASK
#define PHASE_MASK 0x1fff
#endif
#define PH_ON(k) (((PHASE_MASK) >> (k)) & 1)
#ifndef CONV_CUTS
#define CONV_CUTS 1000, 1000, 1000, 1000
#endif
#ifndef MK_SPLIT
#define MK_SPLIT 0
#endif
constexpr int N_PHASES = 20;
struct Args { const float* in[21]; float* out; unsigned char* ws; int ph_lo, ph_hi, flags, pad; };
static_assert(sizeof(Args) == 21 * 8 + 8 + 8 + 16, "Args has no padding");

__device__ __forceinline__ unsigned char* ws_of(const Args& a) { size_t z = 0; asm volatile("" : "+s"(z)); return a.ws + z; }
__device__ __forceinline__ const float* in_of(const Args& a, int i) { asm volatile("" : "+s"(i)); return a.in[i]; }

__global__ void __launch_bounds__(NWAVES * 64, 2) trunk_fwd(Args args) {
    extern __shared__ __attribute__((aligned(16))) unsigned char lds_raw[];
    LAS unsigned char* lds = (LAS unsigned char*)lds_raw;
    volatile LAS unsigned* MISC = (volatile LAS unsigned*)(lds + MISC_OFF);
    const int G = gridDim.x; const int bx = blockIdx.x; const int vcu = (G % 8 == 0) ? (bx % 8) * (G / 8) + bx / 8 : bx;
    for (int u = threadIdx.x; u < (LDS_BYTES - LDSCTL_OFF) / 4; u += NWAVES * 64) ((LAS unsigned*)(lds + LDSCTL_OFF))[u] = 0u;
    __syncthreads();
    XcdBarrier bar; bar.bar = (unsigned*)(args.ws + WS_CTL) + CW_BAR; bar.x = 0; bar.st = nullptr;
    if (!MK_SPLIT) bar = xcd_barrier_post((unsigned*)(args.ws + WS_CTL) + CW_BAR, MISC + 8);
    const int lo = args.ph_lo, hi = args.ph_hi;
#define IN(k) (lo <= (k) && (k) < hi)
#define SEAM(k) do { if (!MK_SPLIT && IN((k) + 1)) xcd_barrier(bar); } while (0)
    const int NGW = G * NWAVES;
#define NSPARE(nunits) (MK_SPLIT ? 0 : (G - (((nunits) + (((nunits) + G - 1) / G) - 1) / (((nunits) + G - 1) / G))))
#define CONV_SLICE(k, nc) do { } while (0)
#define PH_TID() int tz_ = threadIdx.x; asm volatile("" : "+v"(tz_)); const int tid = tz_, lane = tz_ & 63, wave = __builtin_amdgcn_readfirstlane(tz_ >> 6), gw = vcu * NWAVES + wave; (void)tid; (void)lane; (void)gw

    if (PH_ON(0) && IN(0)) {
        unsigned char* ws = ws_of(args); PH_TID();
        P0Args a; a.x = in_of(args, 0); a.mix_norm_w = in_of(args, 1); a.w_in = in_of(args, 2); a.lbl = in_of(args, 3); a.gk_up_w = in_of(args, 4); a.w_proj_a = in_of(args, 8); a.w_proj_b = in_of(args, 9); a.w_out = in_of(args, 10);
        a.ffn_norm_w = in_of(args, 11); a.dense_w_gate = in_of(args, 12); a.dense_w_up = in_of(args, 13); a.dense_w_down = in_of(args, 14); a.moe_w_gate = in_of(args, 17); a.moe_w_up = in_of(args, 18); a.moe_w_down = in_of(args, 19); a.ws = ws;
        { Conv8Src c8; c8.wg = a.moe_w_gate; c8.wu = a.moe_w_up; c8.wd = a.moe_w_down; c8.fw = a.ffn_norm_w + D; c8.win = a.w_in; c8.mw = a.mix_norm_w;
          conv8_range(0, I8_TOT, vcu * NWAVES + wave, G * NWAVES, c8, ws, lane); }
        p0_prologue(a, lds, vcu, G, wave, lane);
        SEAM(0);
    }
    for (int layer = 0; layer < DEPTH; ++layer) {
        const int pb = 1 + 9 * layer;
#define LP_SETUP() LaPtrs LP; LP.Q = (bf16*)(ws + WS_Q); LP.Kb = (bf16*)(ws + WS_K); LP.V = (bf16*)(ws + WS_V); LP.SG = (bf16*)(ws + WS_SG); LP.Y = (bf16*)(ws + WS_Y); LP.SP = (bf16*)(ws + WS_SP); \
        LP.Gf = (float*)(ws + WS_G); LP.LS = (bf16*)(ws + WS_LS); LP.DEC = (float*)(ws + WS_DEC); LP.ER = (float*)(ws + WS_ER); LP.nwa = nullptr; LP.nwb = nullptr;
        if (PH_ON(1) && IN(pb + 0)) {
            unsigned char* ws = ws_of(args); PH_TID();
            { SchedDense8 S; S.A = (const char*)(ws + WS_XB8); S.Bt = (const char*)(ws + WS_WIN8 + (size_t)layer * 4096 * D); S.nM = T / 256; S.nN = 16; S.G = G; S.c = bx; S.skip_epi = args.flags & 1; S.shape(D, D);
              EpiIn8 E; E.rsq = (const float*)(ws + WS_RSP) + (size_t)(2 * layer) * T * 8; E.M = ws + WS_M; E.rst = (LAS const float*)(lds + RST_OFF);
              stage_row_scales(lds, S, E.rsq, tid);
              pg8::gemm_phase<EpiIn8, SchedDense8, true>(lds + RING_OFF, S, E); }
            __syncthreads();
            { const int nc = NSPARE((T / 256) * NIN_BF);
              SchedDense S; S.A = (const char*)(ws + WS_XB); S.Bt = (const char*)((bf16*)(ws + WS_WIN) + (size_t)layer * NIN * D); S.nM = bx < nc ? 0 : T / 256; S.nN = NIN_BF; S.G = G - nc; S.c = bx < nc ? 0 : bx - nc; S.skip_epi = args.flags & 1; S.shape(D, D);
              EpiIn E; E.rsq = (const float*)(ws + WS_RSP) + (size_t)(2 * layer) * T * 8; E.Q = (bf16*)(ws + WS_Q); E.Kb = (bf16*)(ws + WS_K); E.V = (bf16*)(ws + WS_V); E.SG = (bf16*)(ws + WS_SG); E.M = (bf16*)(ws + WS_M); E.Gf = (float*)(ws + WS_G);
              E.lbv = (const float*)(ws + WS_LBV) + layer * 1024; E.gkb = in_of(args, 5) + layer * 512; E.rst = (LAS const float*)(lds + RST_OFF); E.lbl = (LAS const float*)(lds + LBL_OFF);
              if (tid < 256) *(LAS f32x4*)(lds + LBL_OFF + 16 * tid) = *(const f32x4*)(E.lbv + 4 * tid);
              stage_row_scales(lds, S, E.rsq, tid);
              pg8::gemm_phase<EpiIn, SchedDense, true>(lds + RING_OFF, S, E); }
            SEAM(pb + 0);
        }
        if (PH_ON(2) && IN(pb + 1)) {
            unsigned char* ws = ws_of(args); PH_TID(); LP_SETUP();
            { ARegs R; la_a_load(R, LP, (bx % (NHEADS * NCH)) % NHEADS, (bx % (NHEADS * NCH)) / NHEADS, tid);
              for (int u = bx; u < NHEADS * NCH; u += G) { const int un = u + G; la_a_unit(LP, lds, u % NHEADS, u / NHEADS, tid, wave, lane, R, un < NHEADS * NCH, un % NHEADS, un / NHEADS); } }
            SEAM(pb + 1);
        }
        if (PH_ON(3) && IN(pb + 2)) {
            unsigned char* ws = ws_of(args); PH_TID(); LP_SETUP();
            la_b_scan(LP, lds, bx, G, tid);
            SEAM(pb + 2);
        }
        if (PH_ON(4) && IN(pb + 3)) {
            unsigned char* ws = ws_of(args); PH_TID(); LP_SETUP(); LP.nwa = in_of(args, 6) + layer * 128; LP.nwb = in_of(args, 7) + layer * 256;
            { CRegs R; la_c_load(R, LP, (bx % (NHEADS * NCH)) % NHEADS, (bx % (NHEADS * NCH)) / NHEADS, tid);
              for (int u = bx; u < NHEADS * NCH; u += G) { const int un = u + G; la_c_unit(LP, lds, u % NHEADS, u / NHEADS, tid, wave, lane, R, un < NHEADS * NCH, un % NHEADS, un / NHEADS); } }
            SEAM(pb + 3);
        }
        if (PH_ON(5) && IN(pb + 4)) {
            unsigned char* ws = ws_of(args); PH_TID();
            SchedProj S; S.Y = (const char*)(ws + WS_Y); S.Wa = (const char*)((bf16*)(ws + WS_WPA) + (size_t)layer * D * 1024); S.Wb = (const char*)((bf16*)(ws + WS_WPB) + (size_t)layer * D * 1024); S.G = G; S.c = bx; S.skip_epi = args.flags & 1; S.ldaB = D * 2; S.ldbB = 1024 * 2; S.KB = 1024 * 2;
            EpiProj E; E.M = ws + WS_M; E.MG = (bf16*)(ws + WS_MG);
            pg8::gemm_phase<EpiProj, SchedProj, false>(lds + RING_OFF, S, E);
            SEAM(pb + 4);
        }
        if (PH_ON(6) && IN(pb + 5)) {
            unsigned char* ws = ws_of(args); PH_TID();
            SchedDense S; S.A = (const char*)(ws + WS_MG); S.Bt = (const char*)((bf16*)(ws + WS_WOUT) + (size_t)layer * D * D); S.nM = T / 256; S.nN = D / 256; S.G = G; S.c = bx; S.skip_epi = args.flags & 1; S.shape(D, D);
            EpiRes E; E.xb = (bf16*)(ws + WS_XB); E.rsp_out = (float*)(ws + WS_RSP) + (size_t)(layer == 0 ? 1 : 2) * T * 8; E.part = (LAS float*)(lds + PART_OFF);
            E.x8 = nullptr;
            pg8::gemm_phase<EpiRes, SchedDense, true>(lds + RING_OFF, S, E);
            SEAM(pb + 5);
        }
        if (layer == 0) {
            if (PH_ON(7) && IN(pb + 6)) {
                unsigned char* ws = ws_of(args); PH_TID();
                const int nc = NSPARE((T / 256) * ((2 * DFF) / 256));
                if (bx < nc) { if (!(args.flags & 1)) CONV_SLICE(2, nc); }
                SchedDense S; S.A = (const char*)(ws + WS_XB); S.Bt = (const char*)(ws + WS_WGU0); S.nM = bx < nc ? 0 : T / 256; S.nN = (2 * DFF) / 256; S.G = G - nc; S.c = bx < nc ? 0 : bx - nc; S.skip_epi = args.flags & 1; S.shape(D, D);
                EpiGU E; E.rsq = (const float*)(ws + WS_RSP) + (size_t)1 * T * 8; E.H = (bf16*)(ws + WS_H); E.ldh = DFF; E.rst = (LAS const float*)(lds + RST_OFF);
                stage_row_scales(lds, S, E.rsq, tid);
                pg8::gemm_phase<EpiGU, SchedDense, true>(lds + RING_OFF, S, E);
                SEAM(pb + 6);
            }
            if (PH_ON(8) && IN(pb + 7)) {
                unsigned char* ws = ws_of(args); PH_TID();
                SchedDense S; S.A = (const char*)(ws + WS_H); S.Bt = (const char*)(ws + WS_WD0); S.nM = T / 256; S.nN = D / 256; S.G = G; S.c = bx; S.skip_epi = args.flags & 1; S.shape(DFF, DFF);
                EpiRes E; E.xb = (bf16*)(ws + WS_XB); E.rsp_out = (float*)(ws + WS_RSP) + (size_t)2 * T * 8; E.part = (LAS float*)(lds + PART_OFF); E.x8 = ws + WS_XB8;
                pg8::gemm_phase<EpiRes, SchedDense, true>(lds + RING_OFF, S, E);
                SEAM(pb + 8);
            }
        } else {
            if (PH_ON(9) && IN(pb + 6)) {
                unsigned char* ws = ws_of(args); PH_TID();
                MoePtrs MP; MP.XB = (const bf16*)(ws + WS_XB); MP.router_w = in_of(args, 15); MP.router_b = in_of(args, 16); MP.fnw = in_of(args, 11) + D; MP.counts = (unsigned*)(ws + WS_CTL) + CW_CNT;
                MP.list = (int*)(ws + WS_LIST); MP.X8 = ws + WS_X8; MP.tslot = (int*)(ws + WS_TSLOT); MP.tw = (float*)(ws + WS_TW);
                moe_router(MP, lds, gw, NGW, wave, lane);
                SEAM(pb + 6);
            }
            if (PH_ON(10) && IN(pb + 7)) {
                unsigned char* ws = ws_of(args); PH_TID();
                SchedMoeGU S; S.X8 = (const char*)(ws + WS_X8); S.W = (const char*)(ws + WS_WGUE); S.list = (const int*)(ws + WS_LIST); S.mt.load((const unsigned*)(ws + WS_CTL) + CW_CNT); S.G = G; S.c = bx; S.skip_epi = args.flags & 1; S.ldaB = D; S.ldbB = D; S.KB = D;
                EpiGUMoe E; E.ACT8 = ws + WS_ACT; E.mt = S.mt;
                pg8::gemm_phase<EpiGUMoe, SchedMoeGU, true>(lds + RING_OFF, S, E);
                SEAM(pb + 7);
            }
            if (PH_ON(11) && IN(pb + 8)) {
                unsigned char* ws = ws_of(args); PH_TID();
                SchedMoeDN S; S.A = (const char*)(ws + WS_ACT); S.W = (const char*)(ws + WS_WDE); S.mt.load((const unsigned*)(ws + WS_CTL) + CW_CNT); S.G = G; S.c = bx; S.skip_epi = args.flags & 1; S.ldaB = DFFE; S.ldbB = DFFE; S.KB = DFFE / 2;
                EpiDnMoe E; E.YP = (bf16*)(ws + WS_YP);
                pg8::gemm_phase<EpiDnMoe, SchedMoeDN, true>(lds + RING_OFF, S, E);
                SEAM(pb + 8);
            }
        }
    }
    if (PH_ON(12) && IN(19)) {
        unsigned char* ws = ws_of(args); PH_TID();
        MoeTiles mt; mt.load((const unsigned*)(ws + WS_CTL) + CW_CNT);
        final_phase((const bf16*)(ws + WS_XB), (const bf16*)(ws + WS_YP), (const int*)(ws + WS_TSLOT), (const float*)(ws + WS_TW), mt, in_of(args, 20), args.out, gw, NGW, lane);
    }
#undef IN
#undef SEAM
#undef LP_SETUP
#undef CONV_SLICE
#undef PH_TID
}

extern "C" void kernel_launch(void* const* d_in, const int* in_sizes, int n_in, void* d_out, int out_size, void* d_ws, size_t ws_size, hipStream_t stream) {
    static int grid = 0;
    if (grid == 0) {
        if (n_in != 21 || in_sizes[0] != T * D || out_size != T * D || ws_size < WS_END) { fprintf(stderr, "kernel_launch: unexpected shapes (n_in %d, in0 %d, out %d, ws %zu < %zu); nothing launched\n", n_in, n_in > 0 ? in_sizes[0] : -1, out_size, ws_size, (size_t)WS_END); grid = -1; return; }
        int dev = 0, cus = 0, per_cu = 0;
        if (hipGetDevice(&dev) != hipSuccess || hipDeviceGetAttribute(&cus, hipDeviceAttributeMultiprocessorCount, dev) != hipSuccess) { grid = -1; return; }
        if (hipFuncSetAttribute((const void*)trunk_fwd, hipFuncAttributeMaxDynamicSharedMemorySize, LDS_BYTES) != hipSuccess) { fprintf(stderr, "kernel_launch: hipFuncSetAttribute failed\n"); grid = -1; return; }
        if (hipOccupancyMaxActiveBlocksPerMultiprocessor(&per_cu, (const void*)trunk_fwd, NWAVES * 64, LDS_BYTES) != hipSuccess || per_cu < 1) { fprintf(stderr, "kernel_launch: occupancy query says %d blocks per CU\n", per_cu); }
        (void)hipGetLastError();
        grid = cus;
    }
    if (grid < 0) return;
    if (hipMemsetAsync((char*)d_ws + WS_CTL, 0, CTL_ZERO_BYTES, stream) != hipSuccess) return;
    Args a{};
    for (int i = 0; i < 21; ++i) a.in[i] = (const float*)d_in[i];
    a.out = (float*)d_out; a.ws = (unsigned char*)d_ws;
#if MK_SPLIT
    for (int p = 0; p < N_PHASES; ++p) {
        if (p == 9) continue;
        a.ph_lo = p; a.ph_hi = p + 1;
        hipLaunchKernelGGL(trunk_fwd, dim3(grid), dim3(NWAVES * 64), LDS_BYTES, stream, a);
    }
#else
    a.ph_lo = 0; a.ph_hi = N_PHASES;
    hipLaunchKernelGGL(trunk_fwd, dim3(grid), dim3(NWAVES * 64), LDS_BYTES, stream, a);
#ifdef PROBE_EXTRA
    { const int extra[] = {PROBE_EXTRA};
      for (int k = 0; k < (int)(sizeof(extra) / sizeof(extra[0])); ++k) { a.ph_lo = extra[k] & 255; a.ph_hi = (extra[k] & 255) + 1; a.flags = extra[k] >> 8; hipLaunchKernelGGL(trunk_fwd, dim3(grid), dim3(NWAVES * 64), LDS_BYTES, stream, a); } }
#endif
#endif
}
```
